# Optimizing an MI355X kernel written in HIP

```python
import jax, jax.numpy as jnp
from jax import lax
import numpy as np

D_MODEL = 1024
BATCH = 4
SEQ = 4096
DEPTH = 2

N_MIXERS = 2
N_ATTN_LAYERS = (DEPTH + 1) // 2
N_RWKV_LAYERS = DEPTH // 2

HEAD_DIM = 64
ATTN_Q_HEADS = D_MODEL // HEAD_DIM
ATTN_KV_HEADS = 4
ATTN_GROUP = ATTN_Q_HEADS // ATTN_KV_HEADS
QKV_WIDTH = (ATTN_Q_HEADS + 2 * ATTN_KV_HEADS) * HEAD_DIM
WINDOW = 128
BLOCK = WINDOW
ROPE_THETA = 10000.0

RWKV_HEAD = 64
RWKV_HEADS = D_MODEL // RWKV_HEAD
DECAY_LORA = 64
ICLR_LORA = 64
GATE_LORA = 160
LNX_EPS = 64e-5

D_FF = 2816
RMS_EPS = 1e-6

kernel_name = "hybrid_swa_sink_rwkv7_macaron"


def rms_norm(x, g):
    xf = x.astype(jnp.float32)
    y = xf * lax.rsqrt(jnp.mean(xf * xf, axis=-1, keepdims=True) + RMS_EPS) * g
    return y.astype(x.dtype)


def swiglu(h, w_in, w_out):
    gu = h @ w_in
    gate, up = gu[..., :D_FF], gu[..., D_FF:]
    return (jax.nn.silu(gate) * up) @ w_out


def rope_tables(seq):
    inv_freq = ROPE_THETA ** (-jnp.arange(0, HEAD_DIM, 2, dtype=jnp.float32) / HEAD_DIM)
    ang = jnp.arange(seq, dtype=jnp.float32)[:, None] * inv_freq[None, :]
    return jnp.cos(ang)[:, None, :], jnp.sin(ang)[:, None, :]


def apply_rope(x, cos, sin):
    xf = x.astype(jnp.float32)
    x1, x2 = xf[..., :HEAD_DIM // 2], xf[..., HEAD_DIM // 2:]
    out = jnp.concatenate([x1 * cos - x2 * sin, x2 * cos + x1 * sin], axis=-1)
    return out.astype(x.dtype)


def swa_sink_attention(h, w_qkv, b_qkv, sinks, w_o):
    B, S, _ = h.shape
    nb = S // BLOCK
    qkv = h @ w_qkv + b_qkv
    nq = ATTN_Q_HEADS * HEAD_DIM
    nk = ATTN_KV_HEADS * HEAD_DIM
    q = qkv[..., :nq].reshape(B, S, ATTN_Q_HEADS, HEAD_DIM)
    k = qkv[..., nq:nq + nk].reshape(B, S, ATTN_KV_HEADS, HEAD_DIM)
    v = qkv[..., nq + nk:].reshape(B, S, ATTN_KV_HEADS, HEAD_DIM)
    cos, sin = rope_tables(S)
    q = apply_rope(q, cos, sin)
    k = apply_rope(k, cos, sin)

    qb = q.reshape(B, nb, BLOCK, ATTN_KV_HEADS, ATTN_GROUP, HEAD_DIM)
    pad = ((0, 0), (BLOCK, 0), (0, 0), (0, 0))
    kb = jnp.pad(k, pad).reshape(B, nb + 1, BLOCK, ATTN_KV_HEADS, HEAD_DIM)
    vb = jnp.pad(v, pad).reshape(B, nb + 1, BLOCK, ATTN_KV_HEADS, HEAD_DIM)
    k_band = jnp.concatenate([kb[:, :-1], kb[:, 1:]], axis=2)
    v_band = jnp.concatenate([vb[:, :-1], vb[:, 1:]], axis=2)

    scale = HEAD_DIM ** -0.5
    s = jnp.einsum('bnqhgd,bnkhd->bnhgqk', qb, k_band).astype(jnp.float32) * scale
    qi = jnp.arange(BLOCK)[:, None]
    kj = jnp.arange(2 * BLOCK)[None, :]
    diff = qi - kj + BLOCK
    kpos = jnp.arange(nb)[:, None, None] * BLOCK - BLOCK + kj[None]
    mask = (diff >= 0) & (diff < WINDOW) & (kpos >= 0)
    mask = mask[None, :, None, None]
    s = jnp.where(mask, s, -jnp.inf)
    sink = sinks.astype(jnp.float32).reshape(ATTN_KV_HEADS, ATTN_GROUP)[None, None, :, :, None, None]
    m = jnp.maximum(jnp.max(s, axis=-1, keepdims=True), sink)
    p = jnp.exp(s - m)
    denom = jnp.sum(p, axis=-1, keepdims=True) + jnp.exp(sink - m)
    p = p / denom
    o = jnp.einsum('bnhgqk,bnkhd->bnqhgd', p, v_band.astype(jnp.float32))
    o = o.reshape(B, S, ATTN_Q_HEADS * HEAD_DIM).astype(h.dtype)
    return o @ w_o


def wkv7_scan(r, w, k, v, a, b):
    B, S, H, N = r.shape

    def step(state, inp):
        r_t, w_t, k_t, v_t, a_t, b_t = inp
        sa = jnp.einsum('bhij,bhj->bhi', state, a_t)
        state = (state * w_t[:, :, None, :]
                 + sa[..., None] * b_t[:, :, None, :]
                 + v_t[..., None] * k_t[:, :, None, :])
        y = jnp.einsum('bhij,bhj->bhi', state, r_t)
        return state, y

    xs = tuple(jnp.moveaxis(t, 1, 0) for t in (r, w, k, v, a, b))
    s0 = jnp.zeros((B, H, N, N), jnp.float32)
    _, ys = lax.scan(step, s0, xs)
    return jnp.moveaxis(ys, 0, 1)


def rwkv7_time_mix(h, mix, w_rkv, w_o, w0, w1, w2, a0, a1, a2, g1, g2,
                   k_k, k_a, r_k, lnx_g, lnx_b):
    B, S, D = h.shape
    H, N = RWKV_HEADS, RWKV_HEAD
    xx = jnp.pad(h, ((0, 0), (1, 0), (0, 0)))[:, :-1] - h
    xr = h + xx * mix[0]
    xw = h + xx * mix[1]
    xk = h + xx * mix[2]
    xv = h + xx * mix[3]
    xa = h + xx * mix[4]
    xg = h + xx * mix[5]

    r = xr @ w_rkv[0]
    k = xk @ w_rkv[1]
    v = xv @ w_rkv[2]
    logw = -jax.nn.softplus(-(w0 + jnp.tanh(xw @ w1) @ w2)) - 0.5
    decay = jnp.exp(-jnp.exp(logw.astype(jnp.float32)))
    iclr = jax.nn.sigmoid(a0 + (xa @ a1) @ a2)
    g = jax.nn.sigmoid(xg @ g1) @ g2

    heads = lambda t: t.reshape(B, S, H, N).astype(jnp.float32)
    kk = heads(k * k_k)
    kk = kk / jnp.maximum(jnp.sqrt(jnp.sum(kk * kk, axis=-1, keepdims=True)), 1e-12)
    k = k * (1.0 + (iclr - 1.0) * k_a)

    rh, kh, vh, dh, ih = heads(r), heads(k), heads(v), heads(decay), heads(iclr)
    y = wkv7_scan(rh, dh, kh, vh, -kk, kk * ih)

    mu = jnp.mean(y, axis=-1, keepdims=True)
    var = jnp.mean((y - mu) ** 2, axis=-1, keepdims=True)
    yn = ((y - mu) * lax.rsqrt(var + LNX_EPS)).reshape(B, S, D) * lnx_g + lnx_b
    bonus = (jnp.sum(rh * kh * r_k, axis=-1, keepdims=True) * vh).reshape(B, S, D)
    out = (yn + bonus).astype(h.dtype) * g
    return out @ w_o


def setup_inputs(seed: int = 0) -> dict:
    key = jax.random.key(seed)
    ks = jax.random.split(key, 32)
    f32 = jnp.float32
    nrm = lambda k, shape, s: jax.random.normal(k, shape, f32) * s
    NA, NR, D = N_ATTN_LAYERS, N_RWKV_LAYERS, D_MODEL
    return {
        "x": nrm(ks[0], (BATCH, SEQ, D), 1.0),
        "norm_g": 1.0 + nrm(ks[1], (DEPTH, 6, D), 0.05),
        "ffn_w_in": nrm(ks[2], (DEPTH, 2, D, 2 * D_FF), D ** -0.5),
        "ffn_w_out": nrm(ks[3], (DEPTH, 2, D_FF, D), D_FF ** -0.5),
        "attn_w_qkv": nrm(ks[4], (NA, D, QKV_WIDTH), D ** -0.5),
        "attn_b_qkv": nrm(ks[5], (NA, QKV_WIDTH), 0.02),
        "attn_sinks": nrm(ks[6], (NA, ATTN_Q_HEADS), 1.0),
        "attn_w_o": nrm(ks[7], (NA, ATTN_Q_HEADS * HEAD_DIM, D), (ATTN_Q_HEADS * HEAD_DIM) ** -0.5),
        "rwkv_mix": jax.random.uniform(ks[8], (NR, 6, D), f32),
        "rwkv_w_rkv": nrm(ks[9], (NR, 3, D, D), D ** -0.5),
        "rwkv_w_o": nrm(ks[10], (NR, D, D), D ** -0.5),
        "rwkv_w0": jax.random.uniform(ks[11], (NR, D), f32, minval=-6.0, maxval=-0.5),
        "rwkv_w1": nrm(ks[12], (NR, D, DECAY_LORA), D ** -0.5),
        "rwkv_w2": nrm(ks[13], (NR, DECAY_LORA, D), 0.1 * DECAY_LORA ** -0.5),
        "rwkv_a0": nrm(ks[14], (NR, D), 0.1),
        "rwkv_a1": nrm(ks[15], (NR, D, ICLR_LORA), D ** -0.5),
        "rwkv_a2": nrm(ks[16], (NR, ICLR_LORA, D), 0.3 * ICLR_LORA ** -0.5),
        "rwkv_g1": nrm(ks[17], (NR, D, GATE_LORA), D ** -0.5),
        "rwkv_g2": nrm(ks[18], (NR, GATE_LORA, D), GATE_LORA ** -0.5),
        "rwkv_k_k": 0.85 + nrm(ks[19], (NR, D), 0.05),
        "rwkv_k_a": 1.0 + nrm(ks[20], (NR, D), 0.05),
        "rwkv_r_k": nrm(ks[21], (NR, RWKV_HEADS, RWKV_HEAD), 0.1),
        "rwkv_lnx_g": 1.0 + nrm(ks[22], (NR, D), 0.05),
        "rwkv_lnx_b": nrm(ks[23], (NR, D), 0.02),
    }


def reference(x, norm_g, ffn_w_in, ffn_w_out, attn_w_qkv, attn_b_qkv, attn_sinks, attn_w_o,
              rwkv_mix, rwkv_w_rkv, rwkv_w_o, rwkv_w0, rwkv_w1, rwkv_w2, rwkv_a0, rwkv_a1,
              rwkv_a2, rwkv_g1, rwkv_g2, rwkv_k_k, rwkv_k_a, rwkv_r_k, rwkv_lnx_g, rwkv_lnx_b):
    for i in range(DEPTH):
        g = norm_g[i]
        x = x + 0.5 * rms_norm(swiglu(rms_norm(x, g[0]), ffn_w_in[i, 0], ffn_w_out[i, 0]), g[1])
        h = rms_norm(x, g[2])
        j = i // N_MIXERS
        if i % N_MIXERS == 0:
            m = swa_sink_attention(h, attn_w_qkv[j], attn_b_qkv[j], attn_sinks[j], attn_w_o[j])
        else:
            m = rwkv7_time_mix(h, rwkv_mix[j], rwkv_w_rkv[j], rwkv_w_o[j], rwkv_w0[j], rwkv_w1[j],
                               rwkv_w2[j], rwkv_a0[j], rwkv_a1[j], rwkv_a2[j], rwkv_g1[j],
                               rwkv_g2[j], rwkv_k_k[j], rwkv_k_a[j], rwkv_r_k[j],
                               rwkv_lnx_g[j], rwkv_lnx_b[j])
        x = x + rms_norm(m, g[3])
        x = x + 0.5 * rms_norm(swiglu(rms_norm(x, g[4]), ffn_w_in[i, 1], ffn_w_out[i, 1]), g[5])
    return x
```

```cpp
#include <hip/hip_runtime.h>
#include <cstdio>
#include <cstdint>
#include <cmath>

typedef unsigned short bf16;
__device__ __forceinline__ float bf2f(bf16 v) { return __uint_as_float(((unsigned)v) << 16); }
__device__ __forceinline__ bf16 f2bf(float f) { unsigned u = __float_as_uint(f); return (bf16)((u + 0x7fffu + ((u >> 16) & 1u)) >> 16); }

constexpr int BATCH = 4, SEQ = 4096, D = 1024, M = BATCH * SEQ, DFF = 2816, NQKV = 1536, NH = 16, NKV = 4, HD = 64, WIN = 128;
constexpr float RMS_EPS = 1e-6f, LNX_EPS = 64e-5f;

template <class Op>
__global__ void __launch_bounds__(256) ngemm(Op op) {
    __shared__ float As[16][65];
    __shared__ float W1[16][65];
    __shared__ float W2[16][65];
    const int tx = threadIdx.x & 15, ty = threadIdx.x >> 4;
    const int m0 = blockIdx.y * 64, n0 = blockIdx.x * 64;
    float a1[4][4], a2[4][4];
#pragma unroll
    for (int i = 0; i < 4; ++i)
#pragma unroll
        for (int j = 0; j < 4; ++j) { a1[i][j] = 0.f; a2[i][j] = 0.f; }
    for (int k0 = 0; k0 < op.K; k0 += 16) {
#pragma unroll
        for (int e = 0; e < 4; ++e) { const int idx = threadIdx.x * 4 + e, r = idx >> 4, kk = idx & 15; As[kk][r] = op.loadA(m0 + r, k0 + kk); }
#pragma unroll
        for (int e = 0; e < 4; ++e) { const int idx = threadIdx.x + e * 256, kk = idx >> 6, n = idx & 63, gn = n0 + n;
            W1[kk][n] = gn < op.npairs ? op.W[(size_t)(k0 + kk) * op.ldw + op.col1(gn)] : 0.f;
            if (Op::DUAL) W2[kk][n] = gn < op.npairs ? op.W[(size_t)(k0 + kk) * op.ldw + op.col2(gn)] : 0.f; }
        __syncthreads();
#pragma unroll
        for (int kk = 0; kk < 16; ++kk) {
            float av[4], wv[4], wv2[4];
#pragma unroll
            for (int i = 0; i < 4; ++i) av[i] = As[kk][ty * 4 + i];
#pragma unroll
            for (int j = 0; j < 4; ++j) { wv[j] = W1[kk][tx * 4 + j]; wv2[j] = Op::DUAL ? W2[kk][tx * 4 + j] : 0.f; }
#pragma unroll
            for (int i = 0; i < 4; ++i)
#pragma unroll
                for (int j = 0; j < 4; ++j) { a1[i][j] += av[i] * wv[j]; if (Op::DUAL) a2[i][j] += av[i] * wv2[j]; }
        }
        __syncthreads();
    }
#pragma unroll
    for (int i = 0; i < 4; ++i)
#pragma unroll
        for (int j = 0; j < 4; ++j) { const int m = m0 + ty * 4 + i, n = n0 + tx * 4 + j; if (n < op.npairs) op.store(m, n, a1[i][j], a2[i][j]); }
}

struct OpSwiglu {
    static constexpr bool DUAL = true;
    const bf16* A; const float* W; bf16* O; int K, ldw, npairs, pad;
    __device__ float loadA(int m, int k) const { return bf2f(A[(size_t)m * D + k]); }
    __device__ int col1(int n) const { return n; }
    __device__ int col2(int n) const { return DFF + n; }
    __device__ void store(int m, int n, float g, float u) const { const float s = g / (1.f + expf(-g)); O[(size_t)m * DFF + n] = f2bf(s * u); }
};
struct OpF32 {
    static constexpr bool DUAL = false;
    const bf16* A; const float* W; float* O; int K, ldw, npairs, lda;
    __device__ float loadA(int m, int k) const { return bf2f(A[(size_t)m * lda + k]); }
    __device__ int col1(int n) const { return n; }
    __device__ int col2(int n) const { return n; }
    __device__ void store(int m, int n, float a, float) const { O[(size_t)m * npairs + n] = a; }
};
struct OpQKrope {
    static constexpr bool DUAL = true;
    const bf16* A; const float* W; const float* bias; bf16* Q; bf16* Kb; int K, ldw, npairs, pad;
    __device__ float loadA(int m, int k) const { return bf2f(A[(size_t)m * D + k]); }
    __device__ int col1(int n) const { return (n >> 5) * 64 + (n & 31); }
    __device__ int col2(int n) const { return (n >> 5) * 64 + (n & 31) + 32; }
    __device__ void store(int m, int n, float a, float b) const {
        const int hh = n >> 5, d = n & 31, c1 = hh * 64 + d;
        const float x1 = a + bias[c1], x2 = b + bias[c1 + 32];
        const float pos = (float)(m % SEQ), inv = powf(10000.f, -(float)(2 * d) / 64.f), ang = pos * inv;
        const float cs = cosf(ang), sn = sinf(ang);
        const float o1 = x1 * cs - x2 * sn, o2 = x2 * cs + x1 * sn;
        if (hh < 16) { Q[(size_t)m * D + hh * 64 + d] = f2bf(o1); Q[(size_t)m * D + hh * 64 + d + 32] = f2bf(o2); }
        else { Kb[(size_t)m * 256 + (hh - 16) * 64 + d] = f2bf(o1); Kb[(size_t)m * 256 + (hh - 16) * 64 + d + 32] = f2bf(o2); }
    }
};
struct OpV {
    static constexpr bool DUAL = false;
    const bf16* A; const float* W; const float* bias; bf16* V; int K, ldw, npairs, pad;
    __device__ float loadA(int m, int k) const { return bf2f(A[(size_t)m * D + k]); }
    __device__ int col1(int n) const { return 1280 + n; }
    __device__ int col2(int n) const { return 1280 + n; }
    __device__ void store(int m, int n, float a, float) const { V[(size_t)m * 256 + n] = f2bf(a + bias[1280 + n]); }
};
struct OpRwkvProj {
    static constexpr bool DUAL = false;
    const bf16* XN2; const float* mix; const float* W; bf16* O; int K, ldw, npairs, ldo, act, pad;
    __device__ float loadA(int m, int k) const { const float h = bf2f(XN2[(size_t)m * 2048 + k]), p = bf2f(XN2[(size_t)m * 2048 + 1024 + k]); return h + (p - h) * mix[k]; }
    __device__ int col1(int n) const { return n; }
    __device__ int col2(int n) const { return n; }
    __device__ void store(int m, int n, float a, float) const { float v = a; if (act == 1) v = tanhf(a); else if (act == 2) v = 1.f / (1.f + expf(-a)); O[(size_t)m * ldo + n] = f2bf(v); }
};
struct OpLoraUp {
    static constexpr bool DUAL = false;
    const bf16* A; const float* W; const float* add; float* Of; bf16* Ob; int K, ldw, npairs, lda, kind, pad;
    __device__ float loadA(int m, int k) const { return bf2f(A[(size_t)m * lda + k]); }
    __device__ int col1(int n) const { return n; }
    __device__ int col2(int n) const { return n; }
    __device__ void store(int m, int n, float a, float) const {
        if (kind == 0) { const float x = add[n] + a; const float sp = (x > 20.f) ? 0.f : log1pf(expf(-x));
            const float logw = -sp - 0.5f; Of[(size_t)m * D + n] = expf(-expf(logw)); }
        else if (kind == 1) { const float x = add[n] + a; Ob[(size_t)m * D + n] = f2bf(1.f / (1.f + expf(-x))); }
        else Ob[(size_t)m * D + n] = f2bf(a);
    }
};

__device__ __forceinline__ float wave_sum(float v) {
#pragma unroll
    for (int o = 1; o < 64; o <<= 1) v += __shfl_xor(v, o);
    return v;
}
__global__ void __launch_bounds__(256) k_prenorm(const float* x, const float* g, bf16* XN) {
    const int lane = threadIdx.x & 63, m = blockIdx.x * 4 + (threadIdx.x >> 6);
    float v[16]; float ss = 0.f;
#pragma unroll
    for (int j = 0; j < 16; ++j) { v[j] = x[(size_t)m * D + j * 64 + lane]; ss += v[j] * v[j]; }
    const float r = rsqrtf(wave_sum(ss) * (1.f / D) + RMS_EPS);
#pragma unroll
    for (int j = 0; j < 16; ++j) XN[(size_t)m * D + j * 64 + lane] = f2bf(v[j] * r * g[j * 64 + lane]);
}
__global__ void __launch_bounds__(256) k_np(const float* base, const float* F, const float* gpost, const float* gpre, float* xo, bf16* XN, float scale, int mode) {
    const int lane = threadIdx.x & 63, m = blockIdx.x * 4 + (threadIdx.x >> 6);
    float f[16], v[16]; float ss = 0.f;
#pragma unroll
    for (int j = 0; j < 16; ++j) { f[j] = F[(size_t)m * D + j * 64 + lane]; ss += f[j] * f[j]; }
    const float r1 = rsqrtf(wave_sum(ss) * (1.f / D) + RMS_EPS);
    float s2 = 0.f;
#pragma unroll
    for (int j = 0; j < 16; ++j) { const int c = j * 64 + lane; v[j] = base[(size_t)m * D + c] + scale * (f[j] * r1 * gpost[c]); s2 += v[j] * v[j]; xo[(size_t)m * D + c] = v[j]; }
    if (mode == 0) return;
    const float r2 = rsqrtf(wave_sum(s2) * (1.f / D) + RMS_EPS);
#pragma unroll
    for (int j = 0; j < 16; ++j) { const int c = j * 64 + lane; const bf16 o = f2bf(v[j] * r2 * gpre[c]);
        if (mode == 1) XN[(size_t)m * D + c] = o;
        else { XN[(size_t)m * 2048 + c] = o; if ((m % SEQ) != SEQ - 1) XN[(size_t)(m + 1) * 2048 + 1024 + c] = o; if ((m % SEQ) == 0) XN[(size_t)m * 2048 + 1024 + c] = 0; } }
}

__global__ void __launch_bounds__(256) k_attn(const bf16* Q, const bf16* Kb, const bf16* Vb, const float* sinks, bf16* O) {
    __shared__ float ps[4][128];
    const int lane = threadIdx.x & 63, w = threadIdx.x >> 6, gw = blockIdx.x * 4 + w;
    const int m = gw >> 4, h = gw & 15, hk = h >> 2, pos = m % SEQ;
    float q[64];
#pragma unroll
    for (int d = 0; d < 64; ++d) q[d] = bf2f(Q[(size_t)m * D + h * 64 + d]);
    float s[2];
#pragma unroll
    for (int t = 0; t < 2; ++t) { const int off = lane + 64 * t;
        const int kp = pos - off; float acc = -INFINITY;
        if (kp >= 0) { acc = 0.f; const bf16* kr = Kb + (size_t)(m - off) * 256 + hk * 64;
#pragma unroll
            for (int d = 0; d < 64; ++d) acc += q[d] * bf2f(kr[d]);
            acc *= 0.125f; }
        s[t] = acc; }
    const float sink = sinks[h];
    float mx = fmaxf(s[0], s[1]);
#pragma unroll
    for (int o = 1; o < 64; o <<= 1) mx = fmaxf(mx, __shfl_xor(mx, o));
    mx = fmaxf(mx, sink);
    const float p0 = expf(s[0] - mx), p1 = expf(s[1] - mx);
    const float den = wave_sum(p0 + p1) + expf(sink - mx);
    ps[w][lane] = p0 / den; ps[w][lane + 64] = p1 / den;
    __syncthreads();
    float o = 0.f;
    for (int off = 0; off < 128; ++off) { if (pos - off < 0) break; o += ps[w][off] * bf2f(Vb[(size_t)(m - off) * 256 + hk * 64 + lane]); }
    O[(size_t)m * D + h * 64 + lane] = f2bf(o);
}

__global__ void __launch_bounds__(64) k_scan(const bf16* R, const bf16* Kx, const bf16* V, const float* DEC, const bf16* ICL, const bf16* GB,
                                            const float* k_k, const float* k_a, const float* r_k, const float* lnx_g, const float* lnx_b, bf16* Y) {
    __shared__ float sv[5][64];
    const int lane = threadIdx.x, b = blockIdx.x >> 4, h = blockIdx.x & 15, c = h * 64 + lane;
    float S[64];
#pragma unroll
    for (int j = 0; j < 64; ++j) S[j] = 0.f;
    const float kk_c = k_k[c], ka_c = k_a[c], rk_c = r_k[c], lg = lnx_g[c], lb = lnx_b[c];
    for (int t = 0; t < SEQ; ++t) {
        const size_t o = (size_t)(b * SEQ + t) * D + c;
        const float r = bf2f(R[o]), k = bf2f(Kx[o]), v = bf2f(V[o]), w = DEC[o], ic = bf2f(ICL[o]), g = bf2f(GB[o]);
        float kk = k * kk_c; const float nrm = sqrtf(wave_sum(kk * kk)); kk = kk / fmaxf(nrm, 1e-12f);
        const float k2 = k * (1.f + (ic - 1.f) * ka_c);
        __syncthreads();
        sv[0][lane] = r; sv[1][lane] = w; sv[2][lane] = k2; sv[3][lane] = -kk; sv[4][lane] = kk * ic;
        __syncthreads();
        float sa = 0.f;
#pragma unroll
        for (int j = 0; j < 64; ++j) sa += S[j] * sv[3][j];
        float y = 0.f;
#pragma unroll
        for (int j = 0; j < 64; ++j) { S[j] = S[j] * sv[1][j] + sa * sv[4][j] + v * sv[2][j]; y += S[j] * sv[0][j]; }
        const float mu = wave_sum(y) * (1.f / 64.f); const float dy = y - mu; const float var = wave_sum(dy * dy) * (1.f / 64.f);
        const float yn = dy * rsqrtf(var + LNX_EPS) * lg + lb;
        const float bonus = wave_sum(r * k2 * rk_c) * v;
        Y[o] = f2bf((yn + bonus) * g);
    }
}

constexpr size_t MiB = 1u << 20;
constexpr size_t WS_XN = 0;
constexpr size_t WS_F = 32 * MiB;
constexpr size_t WS_HB = 96 * MiB;
constexpr size_t WS_Q = WS_HB, WS_K = WS_HB + 32 * MiB, WS_V = WS_HB + 40 * MiB, WS_O = WS_HB + 48 * MiB;
constexpr size_t WS_XN2 = WS_HB, WS_LH = WS_HB + 64 * MiB;
constexpr size_t WS_DEC = WS_HB;
constexpr size_t WS_RKV = 184 * MiB;
constexpr size_t WS_ICL = 280 * MiB, WS_GB = 312 * MiB;
constexpr size_t WS_END = 344 * MiB;

extern "C" void kernel_launch(void* const* d_in, const int* in_sizes, int n_in, void* d_out, int out_size, void* d_ws, size_t ws_size, hipStream_t stream) {
    if (n_in != 24 || out_size != M * D || ws_size < WS_END) { fprintf(stderr, "kernel_launch: unexpected shapes n_in %d out %d ws %zu\n", n_in, out_size, ws_size); return; }
    const float* x = (const float*)d_in[0]; const float* ng = (const float*)d_in[1]; const float* win = (const float*)d_in[2]; const float* wout = (const float*)d_in[3];
    const float* wqkv = (const float*)d_in[4]; const float* bqkv = (const float*)d_in[5]; const float* sinks = (const float*)d_in[6]; const float* wo_a = (const float*)d_in[7];
    const float* mix = (const float*)d_in[8]; const float* wrkv = (const float*)d_in[9]; const float* wo_r = (const float*)d_in[10]; const float* w0 = (const float*)d_in[11];
    const float* w1 = (const float*)d_in[12]; const float* w2 = (const float*)d_in[13]; const float* a0 = (const float*)d_in[14]; const float* a1 = (const float*)d_in[15];
    const float* a2 = (const float*)d_in[16]; const float* g1 = (const float*)d_in[17]; const float* g2 = (const float*)d_in[18]; const float* k_k = (const float*)d_in[19];
    const float* k_a = (const float*)d_in[20]; const float* r_k = (const float*)d_in[21]; const float* lnx_g = (const float*)d_in[22]; const float* lnx_b = (const float*)d_in[23];
    float* out = (float*)d_out; unsigned char* ws = (unsigned char*)d_ws;
    bf16* XN = (bf16*)(ws + WS_XN); float* F = (float*)(ws + WS_F); bf16* HB = (bf16*)(ws + WS_HB);
    bf16* Q = (bf16*)(ws + WS_Q); bf16* Kb = (bf16*)(ws + WS_K); bf16* Vb = (bf16*)(ws + WS_V); bf16* OB = (bf16*)(ws + WS_O);
    bf16* XN2 = (bf16*)(ws + WS_XN2); bf16* LH = (bf16*)(ws + WS_LH); float* DEC = (float*)(ws + WS_DEC);
    bf16* RKV = (bf16*)(ws + WS_RKV); bf16* ICL = (bf16*)(ws + WS_ICL); bf16* GB = (bf16*)(ws + WS_GB); bf16* YB = XN;
    const dim3 blk(256);
    auto G = [&](int l, int i) { return ng + (size_t)(l * 6 + i) * D; };
    auto ffn = [&](int l, int f, const float* base, int gpost, float scale, const float* gpre, int mode, bf16* xn_out) {
        OpSwiglu o1{XN, win + (size_t)(l * 2 + f) * D * 2 * DFF, HB, D, 2 * DFF, DFF, 0};
        hipLaunchKernelGGL(ngemm<OpSwiglu>, dim3(DFF / 64, M / 64), blk, 0, stream, o1);
        OpF32 o2{HB, wout + (size_t)(l * 2 + f) * DFF * D, F, DFF, D, D, DFF};
        hipLaunchKernelGGL(ngemm<OpF32>, dim3(D / 64, M / 64), blk, 0, stream, o2);
        hipLaunchKernelGGL(k_np, dim3(M / 4), blk, 0, stream, base, (const float*)F, G(l, gpost), gpre, out, xn_out, scale, mode);
    };
    hipLaunchKernelGGL(k_prenorm, dim3(M / 4), blk, 0, stream, x, G(0, 0), XN);
    ffn(0, 0, x, 1, 0.5f, G(0, 2), 1, XN);
    { OpQKrope o{XN, wqkv, bqkv, Q, Kb, D, NQKV, 640, 0}; hipLaunchKernelGGL(ngemm<OpQKrope>, dim3(10, M / 64), blk, 0, stream, o);
      OpV ov{XN, wqkv, bqkv, Vb, D, NQKV, 256, 0}; hipLaunchKernelGGL(ngemm<OpV>, dim3(4, M / 64), blk, 0, stream, ov); }
    hipLaunchKernelGGL(k_attn, dim3(M * NH / 4), blk, 0, stream, (const bf16*)Q, (const bf16*)Kb, (const bf16*)Vb, sinks, OB);
    { OpF32 o{OB, wo_a, F, D, D, D, D}; hipLaunchKernelGGL(ngemm<OpF32>, dim3(D / 64, M / 64), blk, 0, stream, o); }
    hipLaunchKernelGGL(k_np, dim3(M / 4), blk, 0, stream, (const float*)out, (const float*)F, G(0, 3), G(0, 4), out, XN, 1.0f, 1);
    ffn(0, 1, out, 5, 0.5f, G(1, 0), 1, XN);
    ffn(1, 0, out, 1, 0.5f, G(1, 2), 2, XN2);
    for (int z = 0; z < 3; ++z) { const int mi = (z == 0) ? 0 : (z == 1 ? 2 : 3);
        OpRwkvProj o{XN2, mix + mi * D, wrkv + (size_t)z * D * D, RKV + (size_t)z * M * D, D, D, D, D, 0, 0};
        hipLaunchKernelGGL(ngemm<OpRwkvProj>, dim3(D / 64, M / 64), blk, 0, stream, o); }
    { OpRwkvProj ow{XN2, mix + 1 * D, w1, LH, D, 64, 64, 512, 1, 0};        hipLaunchKernelGGL(ngemm<OpRwkvProj>, dim3(1, M / 64), blk, 0, stream, ow);
      OpRwkvProj oa{XN2, mix + 4 * D, a1, LH + 64, D, 64, 64, 512, 0, 0};   hipLaunchKernelGGL(ngemm<OpRwkvProj>, dim3(1, M / 64), blk, 0, stream, oa);
      OpRwkvProj og{XN2, mix + 5 * D, g1, LH + 128, D, 160, 160, 512, 2, 0}; hipLaunchKernelGGL(ngemm<OpRwkvProj>, dim3(3, M / 64), blk, 0, stream, og); }
    { OpLoraUp ow{LH, w2, w0, DEC, nullptr, 64, D, D, 512, 0, 0};        hipLaunchKernelGGL(ngemm<OpLoraUp>, dim3(D / 64, M / 64), blk, 0, stream, ow);
      OpLoraUp oa{LH + 64, a2, a0, nullptr, ICL, 64, D, D, 512, 1, 0};   hipLaunchKernelGGL(ngemm<OpLoraUp>, dim3(D / 64, M / 64), blk, 0, stream, oa);
      OpLoraUp og{LH + 128, g2, nullptr, nullptr, GB, 160, D, D, 512, 2, 0}; hipLaunchKernelGGL(ngemm<OpLoraUp>, dim3(D / 64, M / 64), blk, 0, stream, og); }
    hipLaunchKernelGGL(k_scan, dim3(BATCH * NH), dim3(64), 0, stream, (const bf16*)RKV, (const bf16*)(RKV + (size_t)M * D), (const bf16*)(RKV + (size_t)2 * M * D), (const float*)DEC,
                       (const bf16*)ICL, (const bf16*)GB, k_k, k_a, r_k, lnx_g, lnx_b, YB);
    { OpF32 o{YB, wo_r, F, D, D, D, D}; hipLaunchKernelGGL(ngemm<OpF32>, dim3(D / 64, M / 64), blk, 0, stream, o); }
    hipLaunchKernelGGL(k_np, dim3(M / 4), blk, 0, stream, (const float*)out, (const float*)F, G(1, 3), G(1, 4), out, XN, 1.0f, 1);
    ffn(1, 1, out, 5, 0.5f, nullptr, 0, XN);
}
```

```cpp
#include <hip/hip_runtime.h>
#include <cstdio>
#include <cstdint>
#include <cmath>

typedef unsigned short bf16;
__device__ __forceinline__ float bf2f(bf16 v) { return __uint_as_float(((unsigned)v) << 16); }
__device__ __forceinline__ bf16 f2bf(float f) { unsigned u = __float_as_uint(f); return (bf16)((u + 0x7fffu + ((u >> 16) & 1u)) >> 16); }

constexpr int BATCH = 4, SEQ = 4096, D = 1024, M = BATCH * SEQ, DFF = 2816, NQKV = 1536, NH = 16, NKV = 4, HD = 64, WIN = 128;
constexpr float RMS_EPS = 1e-6f, LNX_EPS = 64e-5f;

template <class Op>
__global__ void __launch_bounds__(256) ngemm(Op op) {
    __shared__ float As[16][65];
    __shared__ float W1[16][65];
    __shared__ float W2[16][65];
    const int tx = threadIdx.x & 15, ty = threadIdx.x >> 4;
    const int m0 = blockIdx.y * 64, n0 = blockIdx.x * 64;
    float a1[4][4], a2[4][4];
#pragma unroll
    for (int i = 0; i < 4; ++i)
#pragma unroll
        for (int j = 0; j < 4; ++j) { a1[i][j] = 0.f; a2[i][j] = 0.f; }
    for (int k0 = 0; k0 < op.K; k0 += 16) {
#pragma unroll
        for (int e = 0; e < 4; ++e) { const int idx = threadIdx.x * 4 + e, r = idx >> 4, kk = idx & 15; As[kk][r] = op.loadA(m0 + r, k0 + kk); }
#pragma unroll
        for (int e = 0; e < 4; ++e) { const int idx = threadIdx.x + e * 256, kk = idx >> 6, n = idx & 63, gn = n0 + n;
            W1[kk][n] = gn < op.npairs ? op.W[(size_t)(k0 + kk) * op.ldw + op.col1(gn)] : 0.f;
            if (Op::DUAL) W2[kk][n] = gn < op.npairs ? op.W[(size_t)(k0 + kk) * op.ldw + op.col2(gn)] : 0.f; }
        __syncthreads();
#pragma unroll
        for (int kk = 0; kk < 16; ++kk) {
            float av[4], wv[4], wv2[4];
#pragma unroll
            for (int i = 0; i < 4; ++i) av[i] = As[kk][ty * 4 + i];
#pragma unroll
            for (int j = 0; j < 4; ++j) { wv[j] = W1[kk][tx * 4 + j]; wv2[j] = Op::DUAL ? W2[kk][tx * 4 + j] : 0.f; }
#pragma unroll
            for (int i = 0; i < 4; ++i)
#pragma unroll
                for (int j = 0; j < 4; ++j) { a1[i][j] += av[i] * wv[j]; if (Op::DUAL) a2[i][j] += av[i] * wv2[j]; }
        }
        __syncthreads();
    }
#pragma unroll
    for (int i = 0; i < 4; ++i)
#pragma unroll
        for (int j = 0; j < 4; ++j) { const int m = m0 + ty * 4 + i, n = n0 + tx * 4 + j; if (n < op.npairs) op.store(m, n, a1[i][j], a2[i][j]); }
}

struct OpSwiglu {
    static constexpr bool DUAL = true;
    const bf16* A; const float* W; bf16* O; int K, ldw, npairs, pad;
    __device__ float loadA(int m, int k) const { return bf2f(A[(size_t)m * D + k]); }
    __device__ int col1(int n) const { return n; }
    __device__ int col2(int n) const { return DFF + n; }
    __device__ void store(int m, int n, float g, float u) const { const float s = g / (1.f + expf(-g)); O[(size_t)m * DFF + n] = f2bf(s * u); }
};
struct OpF32 {
    static constexpr bool DUAL = false;
    const bf16* A; const float* W; float* O; int K, ldw, npairs, lda;
    __device__ float loadA(int m, int k) const { return bf2f(A[(size_t)m * lda + k]); }
    __device__ int col1(int n) const { return n; }
    __device__ int col2(int n) const { return n; }
    __device__ void store(int m, int n, float a, float) const { O[(size_t)m * npairs + n] = a; }
};
struct OpQKrope {
    static constexpr bool DUAL = true;
    const bf16* A; const float* W; const float* bias; bf16* Q; bf16* Kb; int K, ldw, npairs, pad;
    __device__ float loadA(int m, int k) const { return bf2f(A[(size_t)m * D + k]); }
    __device__ int col1(int n) const { return (n >> 5) * 64 + (n & 31); }
    __device__ int col2(int n) const { return (n >> 5) * 64 + (n & 31) + 32; }
    __device__ void store(int m, int n, float a, float b) const {
        const int hh = n >> 5, d = n & 31, c1 = hh * 64 + d;
        const float x1 = a + bias[c1], x2 = b + bias[c1 + 32];
        const float pos = (float)(m % SEQ), inv = powf(10000.f, -(float)(2 * d) / 64.f), ang = pos * inv;
        const float cs = cosf(ang), sn = sinf(ang);
        const float o1 = x1 * cs - x2 * sn, o2 = x2 * cs + x1 * sn;
        if (hh < 16) { Q[(size_t)m * D + hh * 64 + d] = f2bf(o1); Q[(size_t)m * D + hh * 64 + d + 32] = f2bf(o2); }
        else { Kb[(size_t)m * 256 + (hh - 16) * 64 + d] = f2bf(o1); Kb[(size_t)m * 256 + (hh - 16) * 64 + d + 32] = f2bf(o2); }
    }
};
struct OpV {
    static constexpr bool DUAL = false;
    const bf16* A; const float* W; const float* bias; bf16* V; int K, ldw, npairs, pad;
    __device__ float loadA(int m, int k) const { return bf2f(A[(size_t)m * D + k]); }
    __device__ int col1(int n) const { return 1280 + n; }
    __device__ int col2(int n) const { return 1280 + n; }
    __device__ void store(int m, int n, float a, float) const { V[(size_t)m * 256 + n] = f2bf(a + bias[1280 + n]); }
};
struct OpRwkvProj {
    static constexpr bool DUAL = false;
    const bf16* XN2; const float* mix; const float* W; bf16* O; int K, ldw, npairs, ldo, act, pad;
    __device__ float loadA(int m, int k) const { const float h = bf2f(XN2[(size_t)m * 2048 + k]), p = bf2f(XN2[(size_t)m * 2048 + 1024 + k]); return h + (p - h) * mix[k]; }
    __device__ int col1(int n) const { return n; }
    __device__ int col2(int n) const { return n; }
    __device__ void store(int m, int n, float a, float) const { float v = a; if (act == 1) v = tanhf(a); else if (act == 2) v = 1.f / (1.f + expf(-a)); O[(size_t)m * ldo + n] = f2bf(v); }
};
struct OpLoraUp {
    static constexpr bool DUAL = false;
    const bf16* A; const float* W; const float* add; float* Of; bf16* Ob; int K, ldw, npairs, lda, kind, pad;
    __device__ float loadA(int m, int k) const { return bf2f(A[(size_t)m * lda + k]); }
    __device__ int col1(int n) const { return n; }
    __device__ int col2(int n) const { return n; }
    __device__ void store(int m, int n, float a, float) const {
        if (kind == 0) { const float x = add[n] + a; const float sp = (x > 20.f) ? 0.f : log1pf(expf(-x));
            const float logw = -sp - 0.5f; Of[(size_t)m * D + n] = expf(-expf(logw)); }
        else if (kind == 1) { const float x = add[n] + a; Ob[(size_t)m * D + n] = f2bf(1.f / (1.f + expf(-x))); }
        else Ob[(size_t)m * D + n] = f2bf(a);
    }
};

__device__ __forceinline__ float wave_sum(float v) {
#pragma unroll
    for (int o = 1; o < 64; o <<= 1) v += __shfl_xor(v, o);
    return v;
}
__global__ void __launch_bounds__(256) k_prenorm(const float* x, const float* g, bf16* XN) {
    const int lane = threadIdx.x & 63, m = blockIdx.x * 4 + (threadIdx.x >> 6);
    float v[16]; float ss = 0.f;
#pragma unroll
    for (int j = 0; j < 16; ++j) { v[j] = x[(size_t)m * D + j * 64 + lane]; ss += v[j] * v[j]; }
    const float r = rsqrtf(wave_sum(ss) * (1.f / D) + RMS_EPS);
#pragma unroll
    for (int j = 0; j < 16; ++j) XN[(size_t)m * D + j * 64 + lane] = f2bf(v[j] * r * g[j * 64 + lane]);
}
__global__ void __launch_bounds__(256) k_np(const float* base, const float* F, const float* gpost, const float* gpre, float* xo, bf16* XN, float scale, int mode) {
    const int lane = threadIdx.x & 63, m = blockIdx.x * 4 + (threadIdx.x >> 6);
    float f[16], v[16]; float ss = 0.f;
#pragma unroll
    for (int j = 0; j < 16; ++j) { f[j] = F[(size_t)m * D + j * 64 + lane]; ss += f[j] * f[j]; }
    const float r1 = rsqrtf(wave_sum(ss) * (1.f / D) + RMS_EPS);
    float s2 = 0.f;
#pragma unroll
    for (int j = 0; j < 16; ++j) { const int c = j * 64 + lane; v[j] = base[(size_t)m * D + c] + scale * (f[j] * r1 * gpost[c]); s2 += v[j] * v[j]; xo[(size_t)m * D + c] = v[j]; }
    if (mode == 0) return;
    const float r2 = rsqrtf(wave_sum(s2) * (1.f / D) + RMS_EPS);
#pragma unroll
    for (int j = 0; j < 16; ++j) { const int c = j * 64 + lane; const bf16 o = f2bf(v[j] * r2 * gpre[c]);
        if (mode == 1) XN[(size_t)m * D + c] = o;
        else { XN[(size_t)m * 2048 + c] = o; if ((m % SEQ) != SEQ - 1) XN[(size_t)(m + 1) * 2048 + 1024 + c] = o; if ((m % SEQ) == 0) XN[(size_t)m * 2048 + 1024 + c] = 0; } }
}

__global__ void __launch_bounds__(256) k_attn(const bf16* Q, const bf16* Kb, const bf16* Vb, const float* sinks, bf16* O) {
    __shared__ float ps[4][128];
    const int lane = threadIdx.x & 63, w = threadIdx.x >> 6, gw = blockIdx.x * 4 + w;
    const int m = gw >> 4, h = gw & 15, hk = h >> 2, pos = m % SEQ;
    float q[64];
#pragma unroll
    for (int d = 0; d < 64; ++d) q[d] = bf2f(Q[(size_t)m * D + h * 64 + d]);
    float s[2];
#pragma unroll
    for (int t = 0; t < 2; ++t) { const int off = lane + 64 * t;
        const int kp = pos - off; float acc = -INFINITY;
        if (kp >= 0) { acc = 0.f; const bf16* kr = Kb + (size_t)(m - off) * 256 + hk * 64;
#pragma unroll
            for (int d = 0; d < 64; ++d) acc += q[d] * bf2f(kr[d]);
            acc *= 0.125f; }
        s[t] = acc; }
    const float sink = sinks[h];
    float mx = fmaxf(s[0], s[1]);
#pragma unroll
    for (int o = 1; o < 64; o <<= 1) mx = fmaxf(mx, __shfl_xor(mx, o));
    mx = fmaxf(mx, sink);
    const float p0 = expf(s[0] - mx), p1 = expf(s[1] - mx);
    const float den = wave_sum(p0 + p1) + expf(sink - mx);
    ps[w][lane] = p0 / den; ps[w][lane + 64] = p1 / den;
    __syncthreads();
    float o = 0.f;
    for (int off = 0; off < 128; ++off) { if (pos - off < 0) break; o += ps[w][off] * bf2f(Vb[(size_t)(m - off) * 256 + hk * 64 + lane]); }
    O[(size_t)m * D + h * 64 + lane] = f2bf(o);
}

__global__ void __launch_bounds__(64) k_scan(const bf16* R, const bf16* Kx, const bf16* V, const float* DEC, const bf16* ICL, const bf16* GB,
                                            const float* k_k, const float* k_a, const float* r_k, const float* lnx_g, const float* lnx_b, bf16* Y) {
    __shared__ float sv[5][64];
    const int lane = threadIdx.x, b = blockIdx.x >> 4, h = blockIdx.x & 15, c = h * 64 + lane;
    float S[64];
#pragma unroll
    for (int j = 0; j < 64; ++j) S[j] = 0.f;
    const float kk_c = k_k[c], ka_c = k_a[c], rk_c = r_k[c], lg = lnx_g[c], lb = lnx_b[c];
    for (int t = 0; t < SEQ; ++t) {
        const size_t o = (size_t)(b * SEQ + t) * D + c;
        const float r = bf2f(R[o]), k = bf2f(Kx[o]), v = bf2f(V[o]), w = DEC[o], ic = bf2f(ICL[o]), g = bf2f(GB[o]);
        float kk = k * kk_c; const float nrm = sqrtf(wave_sum(kk * kk)); kk = kk / fmaxf(nrm, 1e-12f);
        const float k2 = k * (1.f + (ic - 1.f) * ka_c);
        __syncthreads();
        sv[0][lane] = r; sv[1][lane] = w; sv[2][lane] = k2; sv[3][lane] = -kk; sv[4][lane] = kk * ic;
        __syncthreads();
        float sa = 0.f;
#pragma unroll
        for (int j = 0; j < 64; ++j) sa += S[j] * sv[3][j];
        float y = 0.f;
#pragma unroll
        for (int j = 0; j < 64; ++j) { S[j] = S[j] * sv[1][j] + sa * sv[4][j] + v * sv[2][j]; y += S[j] * sv[0][j]; }
        const float mu = wave_sum(y) * (1.f / 64.f); const float dy = y - mu; const float var = wave_sum(dy * dy) * (1.f / 64.f);
        const float yn = dy * rsqrtf(var + LNX_EPS) * lg + lb;
        const float bonus = wave_sum(r * k2 * rk_c) * v;
        Y[o] = f2bf((yn + bonus) * g);
    }
}

constexpr size_t MiB = 1u << 20;
namespace pg8 {
#define PG8_LAS __attribute__((address_space(3)))
typedef unsigned short bf16_t;
typedef short bf16x8 __attribute__((ext_vector_type(8)));
typedef float f32x4 __attribute__((ext_vector_type(4)));
typedef unsigned u32x4 __attribute__((ext_vector_type(4)));
constexpr int BM = 256, BK = 64, HALF = 128, HTB = HALF * BK * 2  , STAGE_BYTES = 8 * HTB, NXCD = 8, WGM = 8;

__host__ __device__ __forceinline__ int lds_byte(int r, int c) { const int st = (r >> 4) * 2 + (c >> 5), rr = r & 15, cc = c & 31, ob = rr * 64 + cc * 2; return st * 1024 + (ob ^ (((ob >> 9) & 1) << 5)); }
__host__ __device__ __forceinline__ void stage_rc(int b, int& R, int& C) { const int st = b / 1024, sb = b % 1024, swz = sb ^ (((sb >> 9) & 1) << 5); R = (st >> 1) * 16 + swz / 64; C = (st & 1) * 32 + (swz % 64) / 2; }
__host__ __device__ __forceinline__ int perm32(int rho) { const int n = rho >> 4, i = rho & 15; return 8 * (i >> 2) + 4 * n + (i & 3); }

struct Unit { int pm, pn; };
struct Gemm { const bf16_t* A; const bf16_t* Bt; int M, N, K; };

struct StaticOrder {
    int nM, nN, nwg, G, c;
    __host__ __device__ void init(int M, int N, int G_, int c_) { nM = M / BM; nN = N / BM; nwg = nM * nN; G = G_; c = c_; }
    __host__ __device__ bool next(int i, Unit& u) const {
        const long L = (long)i * G + c; if (L >= nwg) return false;
        int wgid = (int)L; { const int q = nwg / NXCD, r = nwg % NXCD, xcd = wgid % NXCD, off = wgid / NXCD; wgid = (xcd < r ? xcd * (q + 1) : r * (q + 1) + (xcd - r) * q) + off; }
        const int nig = WGM * nN, gid = wgid / nig, fm = gid * WGM, gsz = (nM - fm) < WGM ? (nM - fm) : WGM;
        u.pm = fm + ((wgid % nig) % gsz); u.pn = (wgid % nig) / gsz; return true;
    }
    __device__ __forceinline__ void a_ready(const Unit&) const {}
    __device__ __forceinline__ void done(const Unit&) const {}
};


__device__ __forceinline__ unsigned cvt_pk_bf16(float lo, float hi) { unsigned r; asm volatile("v_cvt_pk_bf16_f32 %0, %1, %2" : "=v"(r) : "v"(lo), "v"(hi)); return r; }
typedef unsigned u32x2 __attribute__((ext_vector_type(2)));
__device__ __forceinline__ float fsigmoid(float x) { return __builtin_amdgcn_rcpf(1.f + __builtin_amdgcn_exp2f(-1.4426950408889634f * x)); }
__device__ __forceinline__ float ftanh(float x) { return 1.f - 2.f * __builtin_amdgcn_rcpf(1.f + __builtin_amdgcn_exp2f(2.885390081777927f * x)); }
__device__ __forceinline__ float swi(float g, float u) { return g * fsigmoid(g) * u; }

struct EpiSwiglu {
    static constexpr bool PERM = true, AFTER_DRAIN = false;
    bf16_t* O;
    __device__ __forceinline__ void operator()(const f32x4 (&acc)[2][2][4][2], const Unit& u, int wr, int wc, int fr, int fq) const {
        const int row0 = u.pm * BM + wr * 64 + fr, col0 = u.pn * 128 + wc * 32 + 8 * fq;
#pragma unroll
        for (int ai = 0; ai < 2; ++ai)
#pragma unroll
            for (int m = 0; m < 4; ++m) { bf16_t* rowp = O + (size_t)(row0 + ai * HALF + m * 16) * DFF + col0;
                const f32x4 g0 = acc[ai][0][m][0], g1 = acc[ai][0][m][1], u0 = acc[ai][1][m][0], u1 = acc[ai][1][m][1];
                u32x4 w; w.x = cvt_pk_bf16(swi(g0[0], u0[0]), swi(g0[1], u0[1])); w.y = cvt_pk_bf16(swi(g0[2], u0[2]), swi(g0[3], u0[3]));
                w.z = cvt_pk_bf16(swi(g1[0], u1[0]), swi(g1[1], u1[1])); w.w = cvt_pk_bf16(swi(g1[2], u1[2]), swi(g1[3], u1[3]));
                *(u32x4*)rowp = w; }
    }
};
struct EpiF32 {
    static constexpr bool PERM = false, AFTER_DRAIN = false;
    float* C; int ldc;
    __device__ __forceinline__ void operator()(const f32x4 (&acc)[2][2][4][2], const Unit& u, int wr, int wc, int fr, int fq) const {
        const int row0 = u.pm * BM + wr * 64 + fr, col0 = u.pn * BM + wc * 32 + 4 * fq;
#pragma unroll
        for (int ai = 0; ai < 2; ++ai)
#pragma unroll
            for (int m = 0; m < 4; ++m) { float* rowp = C + (size_t)(row0 + ai * HALF + m * 16) * ldc + col0;
#pragma unroll
                for (int bj = 0; bj < 2; ++bj)
#pragma unroll
                    for (int n = 0; n < 2; ++n) *(f32x4*)(rowp + bj * HALF + n * 16) = acc[ai][bj][m][n]; }
    }
};
struct EpiQKV {
    static constexpr bool PERM = true, AFTER_DRAIN = false;
    bf16_t* Q; bf16_t* Kb; bf16_t* Vb; const float* bias; const float* cosT; const float* sinT;
    __device__ __forceinline__ void operator()(const f32x4 (&acc)[2][2][4][2], const Unit& u, int wr, int wc, int fr, int fq) const {
        const int row0 = u.pm * BM + wr * 64 + fr, g = 4 * (wc & 1) + fq;
#pragma unroll
        for (int bj = 0; bj < 2; ++bj) {
            const int head = 4 * u.pn + 2 * bj + (wc >> 1), pc = head * 64 + 4 * g;
            const f32x4 b1 = *(const f32x4*)(bias + pc), b2 = *(const f32x4*)(bias + pc + 32);
            bf16_t* dst; int pitch;
            if (head < 16) { dst = Q + head * 64 + 4 * g; pitch = D; } else if (head < 20) { dst = Kb + (head - 16) * 64 + 4 * g; pitch = 256; } else { dst = Vb + (head - 20) * 64 + 4 * g; pitch = 256; }
#pragma unroll
            for (int ai = 0; ai < 2; ++ai)
#pragma unroll
                for (int m = 0; m < 4; ++m) { const int row = row0 + ai * HALF + m * 16;
                    f32x4 x1 = acc[ai][bj][m][0] + b1, x2 = acc[ai][bj][m][1] + b2;
                    if (head < 20) { const int pos = row & (SEQ - 1); const f32x4 cs = *(const f32x4*)(cosT + pos * 32 + 4 * g), sn = *(const f32x4*)(sinT + pos * 32 + 4 * g);
                        const f32x4 o1 = x1 * cs - x2 * sn, o2 = x2 * cs + x1 * sn; x1 = o1; x2 = o2; }
                    u32x2 w1, w2; w1.x = cvt_pk_bf16(x1[0], x1[1]); w1.y = cvt_pk_bf16(x1[2], x1[3]); w2.x = cvt_pk_bf16(x2[0], x2[1]); w2.y = cvt_pk_bf16(x2[2], x2[3]);
                    *(u32x2*)(dst + (size_t)row * pitch) = w1; *(u32x2*)(dst + (size_t)row * pitch + 32) = w2; }
        }
    }
};
struct EpiRwkv1 {
    static constexpr bool PERM = true, AFTER_DRAIN = false;
    bf16_t* RKV; bf16_t* LH;
    __device__ __forceinline__ void operator()(const f32x4 (&acc)[2][2][4][2], const Unit& u, int wr, int wc, int fr, int fq) const {
        const int row0 = u.pm * BM + wr * 64 + fr;
        if (u.pn < 12) {
            bf16_t* O = RKV + (size_t)(u.pn >> 2) * M * D; const int col0 = (u.pn & 3) * 256 + wc * 32 + 8 * fq;
#pragma unroll
            for (int ai = 0; ai < 2; ++ai)
#pragma unroll
                for (int m = 0; m < 4; ++m) { bf16_t* rowp = O + (size_t)(row0 + ai * HALF + m * 16) * D + col0;
#pragma unroll
                    for (int bj = 0; bj < 2; ++bj) { const f32x4 v0 = acc[ai][bj][m][0], v1 = acc[ai][bj][m][1];
                        u32x4 w; w.x = cvt_pk_bf16(v0[0], v0[1]); w.y = cvt_pk_bf16(v0[2], v0[3]); w.z = cvt_pk_bf16(v1[0], v1[1]); w.w = cvt_pk_bf16(v1[2], v1[3]);
                        *(u32x4*)(rowp + bj * HALF) = w; } }
        } else {
#pragma unroll
            for (int bj = 0; bj < 2; ++bj) { const int vc = (u.pn - 12) * 256 + bj * HALF + wc * 32 + 8 * fq; const int kind = vc < 64 ? 1 : (vc < 128 ? 0 : (vc < 288 ? 2 : 3));
#pragma unroll
                for (int ai = 0; ai < 2; ++ai)
#pragma unroll
                    for (int m = 0; m < 4; ++m) { f32x4 v0 = acc[ai][bj][m][0], v1 = acc[ai][bj][m][1];
#pragma unroll
                        for (int e = 0; e < 4; ++e) { if (kind == 1) { v0[e] = ftanh(v0[e]); v1[e] = ftanh(v1[e]); } else if (kind == 2) { v0[e] = fsigmoid(v0[e]); v1[e] = fsigmoid(v1[e]); } else if (kind == 3) { v0[e] = 0.f; v1[e] = 0.f; } }
                        u32x4 w; w.x = cvt_pk_bf16(v0[0], v0[1]); w.y = cvt_pk_bf16(v0[2], v0[3]); w.z = cvt_pk_bf16(v1[0], v1[1]); w.w = cvt_pk_bf16(v1[2], v1[3]);
                        *(u32x4*)(LH + (size_t)(row0 + ai * HALF + m * 16) * 512 + vc) = w; } }
        }
    }
};
struct EpiRwkv2 {
    static constexpr bool PERM = false, AFTER_DRAIN = false;
    float* DEC; bf16_t* ICL; bf16_t* GB; const float* w0; const float* a0;
    template <int KIND> __device__ __forceinline__ void run(const f32x4 (&acc)[2][2][4][2], int row0, int col0) const {
#pragma unroll
        for (int bj = 0; bj < 2; ++bj)
#pragma unroll
            for (int n = 0; n < 2; ++n) { const int col = col0 + bj * HALF + n * 16;
                f32x4 add = (f32x4){0.f, 0.f, 0.f, 0.f}; if (KIND == 0) add = *(const f32x4*)(w0 + col); if (KIND == 1) add = *(const f32x4*)(a0 + col);
#pragma unroll
                for (int ai = 0; ai < 2; ++ai)
#pragma unroll
                    for (int m = 0; m < 4; ++m) { const size_t off = (size_t)(row0 + ai * HALF + m * 16) * D + col; f32x4 x = acc[ai][bj][m][n] + add;
                        if (KIND == 0) { f32x4 o;
#pragma unroll
                            for (int e = 0; e < 4; ++e) o[e] = __builtin_amdgcn_exp2f(-0.6065306597f * 1.4426950408889634f * fsigmoid(x[e]));
                            *(f32x4*)(DEC + off) = o; }
                        else { if (KIND == 1) {
#pragma unroll
                                for (int e = 0; e < 4; ++e) x[e] = fsigmoid(x[e]); }
                            u32x2 w; w.x = cvt_pk_bf16(x[0], x[1]); w.y = cvt_pk_bf16(x[2], x[3]);
                            if (KIND == 1) *(u32x2*)(ICL + off) = w; else *(u32x2*)(GB + off) = w; } } }
    }
    __device__ __forceinline__ void operator()(const f32x4 (&acc)[2][2][4][2], const Unit& u, int wr, int wc, int fr, int fq) const {
        const int row0 = u.pm * BM + wr * 64 + fr, kind = u.pn >> 2, col0 = (u.pn & 3) * 256 + wc * 32 + 4 * fq;
        if (kind == 0) run<0>(acc, row0, col0); else if (kind == 1) run<1>(acc, row0, col0); else run<2>(acc, row0, col0);
    }
};
template <class Epi, class Sched, bool ALIGN_EPI = false, bool SP2 = false>
__device__ __forceinline__ void gemm_phase(PG8_LAS unsigned char* lds, const Gemm g, const Sched& S, const Epi& E) {
    int tid_ = threadIdx.x; asm volatile("" : "+v"(tid_));
    const int tid = tid_, wid = __builtin_amdgcn_readfirstlane(tid >> 6), lane = tid & 63, wr = wid >> 2, wc = wid & 3, fr = lane & 15, fq = lane >> 4;
    const int K = g.K, nt = K / BK;
    unsigned voffA[2], voffB[2];
#pragma unroll
    for (int i = 0; i < 2; ++i) { int R, C; stage_rc(tid * 16 + i * 8192, R, C); const int Rb = Epi::PERM ? ((R & ~31) + perm32(R & 31)) : R;
        voffA[i] = (unsigned)(R * K + C) * 2u; voffB[i] = (unsigned)(Rb * K + C) * 2u; }
    const size_t kstep = (size_t)(BK * 2);
    const size_t hstep = (size_t)HALF * K * 2;
    const size_t tstep = 2 * hstep;
    const unsigned ldsw = (unsigned)wid * 1024u;
    const int aoff = lds_byte(wr * 64 + fr, fq * 8), boff = lds_byte(wc * 32 + fr, fq * 8);
#define PG8_SA(b, h) (((b) * 2 + (h)) * HTB)
#define PG8_SB(b, h) ((4 + (b) * 2 + (h)) * HTB)
#define PG8_STAGE(bufoff, gbase, voff) do { _Pragma("unroll") for (int _i = 0; _i < 2; ++_i) \
        __builtin_amdgcn_global_load_lds((const unsigned*)((const char*)(gbase) + (voff)[_i]), (PG8_LAS unsigned*)(lds + (bufoff) + ldsw + _i * 8192), 16, 0, 0); } while (0)
#define PG8_LDA(dst, b, h) do { _Pragma("unroll") for (int m = 0; m < 4; ++m) _Pragma("unroll") for (int k = 0; k < 2; ++k) dst[m][k] = *(const PG8_LAS bf16x8*)(lds + PG8_SA(b, h) + aoff + m * 2048 + k * 1024); } while (0)
#define PG8_LDB(dst, b, h) do { _Pragma("unroll") for (int n = 0; n < 2; ++n) _Pragma("unroll") for (int k = 0; k < 2; ++k) dst[n][k] = *(const PG8_LAS bf16x8*)(lds + PG8_SB(b, h) + boff + n * 2048 + k * 1024); } while (0)
#define PG8_MMA(ai, bj, At, Bt) do { __builtin_amdgcn_s_setprio(1); _Pragma("unroll") for (int m = 0; m < 4; ++m) _Pragma("unroll") for (int n = 0; n < 2; ++n) _Pragma("unroll") for (int k = 0; k < 2; ++k) \
        acc[ai][bj][m][n] = __builtin_amdgcn_mfma_f32_16x16x32_bf16(Bt[n][k], At[m][k], acc[ai][bj][m][n], 0, 0, 0); __builtin_amdgcn_s_setprio(0); } while (0)
#define PG8_WAIT_V(n) asm volatile("s_waitcnt vmcnt(" #n ")" ::: "memory")
#define PG8_WAIT_L(n) asm volatile("s_waitcnt lgkmcnt(" #n ")" ::: "memory")
#define PG8_BAR __builtin_amdgcn_s_barrier()
#define PG8_SCHED __builtin_amdgcn_sched_barrier(0)
    Unit cur, nxt; int ui = 0;
    if (!S.next(0, cur)) return;
    f32x4 acc[2][2][4][2];
#pragma unroll
    for (int a = 0; a < 2; ++a)
#pragma unroll
        for (int b = 0; b < 2; ++b)
#pragma unroll
            for (int m = 0; m < 4; ++m)
#pragma unroll
                for (int n = 0; n < 2; ++n) acc[a][b][m][n] = (f32x4){0.f, 0.f, 0.f, 0.f};
    bf16x8 At[4][2], B0[2][2], B1[2][2];
    const char* cA = (const char*)g.A + (size_t)cur.pm * tstep; const char* cB = (const char*)g.Bt + (size_t)cur.pn * tstep;
    S.a_ready(cur);
    if constexpr (SP2) {
        PG8_STAGE(PG8_SB(0, 0), cB, voffB); PG8_STAGE(PG8_SB(0, 1), cB + hstep, voffB); PG8_STAGE(PG8_SA(0, 0), cA, voffA); PG8_STAGE(PG8_SA(0, 1), cA + hstep, voffA);
        if (wr == 1) PG8_BAR;
        PG8_WAIT_V(2); PG8_BAR;
        PG8_STAGE(PG8_SB(1, 0), cB + kstep, voffB); PG8_STAGE(PG8_SA(1, 0), cA + kstep, voffA); PG8_STAGE(PG8_SB(1, 1), cB + hstep + kstep, voffB);
        PG8_WAIT_V(6); PG8_BAR;
    } else {
        PG8_STAGE(PG8_SB(0, 0), cB, voffB); PG8_STAGE(PG8_SA(0, 0), cA, voffA); PG8_STAGE(PG8_SB(0, 1), cB + hstep, voffB); PG8_STAGE(PG8_SA(0, 1), cA + hstep, voffA);
        if (wr == 1) PG8_BAR;
        PG8_WAIT_V(4); PG8_BAR;
        PG8_STAGE(PG8_SB(1, 0), cB + kstep, voffB); PG8_STAGE(PG8_SA(1, 0), cA + kstep, voffA); PG8_STAGE(PG8_SB(1, 1), cB + hstep + kstep, voffB);
        PG8_WAIT_V(6); PG8_BAR;
    }
    for (;;) {
        const bool has_next = S.next(ui + 1, nxt);
        const char* nA = has_next ? (const char*)g.A + (size_t)nxt.pm * tstep : cA; const char* nB = has_next ? (const char*)g.Bt + (size_t)nxt.pn * tstep : cB;
        for (int t = 0; t < nt; t += 2) {
            const bool last = (t == nt - 2);
            const char* a1 = cA + (size_t)(t + 1) * kstep;
            const char* a2 = last ? nA : cA + (size_t)(t + 2) * kstep; const char* b2 = last ? nB : cB + (size_t)(t + 2) * kstep;
            const char* a3 = a2 + kstep; const char* b3 = b2 + kstep;
            if (last && has_next) S.a_ready(nxt);
            if constexpr (SP2) {
            PG8_LDB(B0, 0, 0); PG8_LDB(B1, 0, 1); PG8_SCHED; PG8_LDA(At, 0, 0); PG8_STAGE(PG8_SA(1, 1), a1 + hstep, voffA);
            PG8_WAIT_V(8); PG8_WAIT_L(0); PG8_BAR; PG8_MMA(0, 0, At, B0); PG8_MMA(0, 1, At, B1); PG8_BAR; PG8_SCHED;
            PG8_LDA(At, 0, 1); PG8_STAGE(PG8_SB(0, 0), b2, voffB); PG8_STAGE(PG8_SB(0, 1), b2 + hstep, voffB); PG8_STAGE(PG8_SA(0, 0), a2, voffA);
            PG8_WAIT_V(8); PG8_WAIT_L(0); PG8_BAR; PG8_MMA(1, 0, At, B0); PG8_MMA(1, 1, At, B1); PG8_BAR; PG8_SCHED;
            PG8_LDB(B0, 1, 0); PG8_LDB(B1, 1, 1); PG8_SCHED; PG8_LDA(At, 1, 0); PG8_STAGE(PG8_SA(0, 1), a2 + hstep, voffA);
            PG8_WAIT_V(8); PG8_WAIT_L(0); PG8_BAR; PG8_MMA(0, 0, At, B0); PG8_MMA(0, 1, At, B1); PG8_BAR; PG8_SCHED;
            PG8_LDA(At, 1, 1); PG8_STAGE(PG8_SB(1, 0), b3, voffB); PG8_STAGE(PG8_SB(1, 1), b3 + hstep, voffB); PG8_STAGE(PG8_SA(1, 0), a3, voffA);
            PG8_WAIT_V(8); PG8_WAIT_L(0); PG8_BAR; PG8_MMA(1, 0, At, B0); PG8_MMA(1, 1, At, B1); PG8_BAR; PG8_SCHED;
            } else {
            PG8_LDB(B0, 0, 0); PG8_SCHED; PG8_LDA(At, 0, 0); PG8_STAGE(PG8_SA(1, 1), a1 + hstep, voffA);
            PG8_WAIT_L(8); PG8_BAR; PG8_WAIT_L(0); PG8_MMA(0, 0, At, B0); PG8_BAR; PG8_SCHED;
            PG8_LDB(B1, 0, 1); PG8_STAGE(PG8_SB(0, 0), b2, voffB);
            PG8_BAR; PG8_WAIT_L(0); PG8_MMA(0, 1, At, B1); PG8_BAR;
            PG8_LDA(At, 0, 1); PG8_STAGE(PG8_SA(0, 0), a2, voffA);
            PG8_BAR; PG8_WAIT_L(0); PG8_MMA(1, 0, At, B0); PG8_BAR; PG8_SCHED;
            PG8_STAGE(PG8_SB(0, 1), b2 + hstep, voffB);
            PG8_WAIT_V(6); PG8_BAR; PG8_MMA(1, 1, At, B1); PG8_BAR;
            PG8_LDB(B0, 1, 0); PG8_SCHED; PG8_LDA(At, 1, 0); PG8_STAGE(PG8_SA(0, 1), a2 + hstep, voffA);
            PG8_WAIT_L(8); PG8_BAR; PG8_WAIT_L(0); PG8_MMA(0, 0, At, B0); PG8_BAR; PG8_SCHED;
            PG8_LDB(B1, 1, 1); PG8_STAGE(PG8_SB(1, 0), b3, voffB);
            PG8_BAR; PG8_WAIT_L(0); PG8_MMA(0, 1, At, B1); PG8_BAR;
            PG8_LDA(At, 1, 1); PG8_STAGE(PG8_SA(1, 0), a3, voffA);
            PG8_BAR; PG8_WAIT_L(0); PG8_MMA(1, 0, At, B0); PG8_BAR; PG8_SCHED;
            PG8_STAGE(PG8_SB(1, 1), b3 + hstep, voffB);
            PG8_WAIT_V(6); PG8_BAR; PG8_MMA(1, 1, At, B1); PG8_BAR;
            }
        }
        if constexpr (ALIGN_EPI) { if (wr == 0) PG8_BAR; }
        if constexpr (!Epi::AFTER_DRAIN) { E(acc, cur, wr, wc, fr, fq); S.done(cur); }
        if (!has_next) break;
#pragma unroll
        for (int a = 0; a < 2; ++a)
#pragma unroll
            for (int b = 0; b < 2; ++b)
#pragma unroll
                for (int m = 0; m < 4; ++m)
#pragma unroll
                    for (int n = 0; n < 2; ++n) acc[a][b][m][n] = (f32x4){0.f, 0.f, 0.f, 0.f};
        cur = nxt; cA = nA; cB = nB; ++ui;
        if constexpr (ALIGN_EPI) { if (wr == 1) PG8_BAR; }
    }
    PG8_WAIT_V(0);
    if constexpr (!ALIGN_EPI) { if (wr == 0) PG8_BAR; }
    PG8_BAR;
    if constexpr (Epi::AFTER_DRAIN) { E.fused(acc, cur, wr, wc, fr, fq, lds, wid, lane); S.done(cur); }
#undef PG8_SA
#undef PG8_SB
#undef PG8_STAGE
#undef PG8_LDA
#undef PG8_LDB
#undef PG8_MMA
#undef PG8_WAIT_V
#undef PG8_WAIT_L
#undef PG8_BAR
#undef PG8_SCHED
}
}

constexpr int NWAVES = 8;
constexpr int N_PHASES = 22;
constexpr size_t WS_CTL = 0, CTL_ZERO_BYTES = 1 * MiB;
constexpr size_t WS_ROPE = 1 * MiB;
constexpr size_t SZ_WIN = (size_t)2 * DFF * D * 2, SZ_WOUT = (size_t)D * DFF * 2;
constexpr size_t WS_WIN0 = 2 * MiB, WS_WOUT0 = WS_WIN0 + 2 * SZ_WIN, WS_WQKV = WS_WOUT0 + 2 * SZ_WOUT, WS_WOA = WS_WQKV + 3 * MiB;
constexpr size_t WS_WIN1 = 40 * MiB, WS_WOUT1 = WS_WIN1 + 2 * SZ_WIN, WS_WOR = WS_WOUT1 + 2 * SZ_WOUT, WS_W14 = WS_WOR + 2 * MiB, WS_W15 = WS_W14 + 14 * MiB;
constexpr size_t PS_YB = 2 * MiB;
constexpr size_t PS_XN = 92 * MiB;
constexpr size_t PS_F = PS_XN + 32 * MiB;
constexpr size_t PS_RKV = PS_XN;
constexpr size_t PS_HB = PS_F + 64 * MiB;
constexpr size_t PS_Q = PS_HB, PS_K = PS_HB + 32 * MiB, PS_V = PS_HB + 40 * MiB, PS_O = PS_HB + 48 * MiB;
constexpr size_t PS_XN2 = PS_HB, PS_LH = PS_HB + 64 * MiB, PS_DEC = PS_HB;
constexpr size_t PS_ICL = PS_HB + 88 * MiB, PS_GB = PS_ICL + 32 * MiB, PS_END = PS_GB + 32 * MiB;
static_assert(WS_WOA + 2 * MiB == 40 * MiB && WS_W15 + 3 * MiB == 92 * MiB && PS_END == 340 * MiB, "d_ws map");
constexpr int CW_BAR = 4096;
constexpr int RING_OFF = 0, RING_BYTES = 131072, LDSCTL_OFF = RING_BYTES, MISC_OFF = LDSCTL_OFF + 320, LDS_BYTES = 147456;

#define GAS __attribute__((address_space(1)))
#define LAS __attribute__((address_space(3)))
typedef unsigned v4u __attribute__((ext_vector_type(4)));
typedef unsigned v2u __attribute__((ext_vector_type(2)));
typedef float f32x4 __attribute__((ext_vector_type(4)));
typedef GAS unsigned gu32;
#define RLX_AGENT __ATOMIC_RELAXED, __HIP_MEMORY_SCOPE_AGENT
#define LDS_WAIT() asm volatile("s_waitcnt lgkmcnt(0)" ::: "memory")
#define VM_WAIT() asm volatile("s_waitcnt vmcnt(0)" ::: "memory")
__device__ __forceinline__ unsigned pk2(float lo, float hi) { return (unsigned)f2bf(lo) | ((unsigned)f2bf(hi) << 16); }

#define XB_TMO      128
#define XB_XCNT(j)  (256  + 64 * (j))
#define XB_XSUB(j)  (1280 + 64 * (j))
#define XB_XGEN(j)  (2304 + 64 * (j))
#define XB_TOP      3328
#define XB_TOPGEN   3392
#define XCD_BAR_WORDS 3456
#define XB_SPIN_CAP (1u << 18)

__device__ __forceinline__ unsigned xb_ld(unsigned* p)              { return __hip_atomic_load(p, __ATOMIC_RELAXED, __HIP_MEMORY_SCOPE_AGENT); }
__device__ __forceinline__ unsigned xb_add(unsigned* p, unsigned v) { return __hip_atomic_fetch_add(p, v, __ATOMIC_RELAXED, __HIP_MEMORY_SCOPE_AGENT); }
__device__ __forceinline__ unsigned xb_xcc_id() { return (unsigned)__builtin_amdgcn_s_getreg((3 << 11) | 20) & 0xFu; }
#define XB_SPIN(cond, bar) do { unsigned _sp = 0; while (cond) { __builtin_amdgcn_s_sleep(1); \
    if ((++_sp & 255u) == 0u) { if (xb_ld(&(bar)[XB_TMO])) break; if (_sp > XB_SPIN_CAP) { atomicAdd(&(bar)[XB_TMO], 1u); break; } } } } while (0)

struct XcdBarrier {
    unsigned* bar; unsigned x;
    volatile LAS unsigned* st;
};

__device__ __forceinline__ XcdBarrier xcd_barrier_post(unsigned* bar, volatile LAS unsigned* st) {
    XcdBarrier b; b.bar = bar; b.x = xb_xcc_id(); b.st = st;
    if (threadIdx.x == 0) (void)xb_add(&bar[XB_XCNT(b.x)], 1u);
    return b;
}
__device__ __forceinline__ void xcd_barrier_complete(unsigned* bar, unsigned x, unsigned& nloc, unsigned& nx) {
    const unsigned G = gridDim.x * gridDim.y * gridDim.z;
    unsigned sum, cnt, mine, sp = 0u;
    for (;;) {
        sum = 0u; cnt = 0u; mine = 0u;
#pragma unroll
        for (unsigned j = 0; j < 16; ++j) { const unsigned c = xb_ld(&bar[XB_XCNT(j)]); sum += c; cnt += (c > 0u) ? 1u : 0u; mine = (j == x) ? c : mine; }
        if (sum == G) break;
        __builtin_amdgcn_s_sleep(1);
        if ((++sp & 255u) == 0u) { if (xb_ld(&bar[XB_TMO])) break; if (sp > XB_SPIN_CAP) { atomicAdd(&bar[XB_TMO], 1u); break; } }
    }
    nloc = mine > 0u ? mine : 1u; nx = cnt > 0u ? cnt : 1u;
}

__device__ __forceinline__ void xcd_barrier(const XcdBarrier& b) {
    asm volatile("s_waitcnt vmcnt(0)" ::: "memory");
    __syncthreads();
    if (threadIdx.x == 0) {
        unsigned* bar = b.bar;
        __builtin_amdgcn_s_waitcnt(0);
        unsigned nloc = b.st[0], nx = b.st[1];
        if (nloc == 0u) { xcd_barrier_complete(bar, b.x, nloc, nx); b.st[0] = nloc; b.st[1] = nx; }
        const unsigned old = xb_add(&bar[XB_XSUB(b.x)], 1u);
        const unsigned gen = old / nloc;
        if (old + 1u == (gen + 1u) * nloc) {
            __builtin_amdgcn_fence(__ATOMIC_RELEASE, "agent");
            asm volatile("s_waitcnt vmcnt(0)" ::: "memory");
            const unsigned og = xb_add(&bar[XB_TOP], 1u);
            const unsigned tg = og / nx;
            if (og + 1u == (tg + 1u) * nx) xb_add(&bar[XB_TOPGEN], 1u);
            else XB_SPIN(xb_ld(&bar[XB_TOPGEN]) == tg, bar);
            __builtin_amdgcn_fence(__ATOMIC_ACQUIRE, "agent");
            xb_add(&bar[XB_XGEN(b.x)], 1u);
            asm volatile("s_waitcnt vmcnt(0)" ::: "memory");
        } else {
            XB_SPIN(xb_ld(&bar[XB_XGEN(b.x)]) == gen, bar);
            __builtin_amdgcn_fence(__ATOMIC_ACQUIRE, "agent");
            asm volatile("s_waitcnt vmcnt(0)" ::: "memory");
        }
    }
    __syncthreads();
}


struct Args { const float* in[24]; float* out; unsigned char* ws; int ph_lo, ph_hi, li, pad; };
struct Frame {
    LAS unsigned char* lds; volatile LAS unsigned* MISC; gu32* ctl;
    int tid, lane, wave, vcu, G, gw, NGW;
};

template <int MODE> __device__ __forceinline__ int dst_row(int n) {
    if (MODE == 1) { const int up = n >= DFF, nn = up ? n - DFF : n; return 256 * (nn >> 7) + 128 * up + (nn & 127); }
    if (MODE == 2) { const int head = n >> 6, d = n & 63, dd = d & 31; return head * 64 + 8 * (dd >> 2) + 4 * (d >> 5) + (dd & 3); }
    return n;
}
template <int MODE> __device__ __forceinline__ void p0_transpose_item(const float* W, int K, int N, bf16* WT, int ldd, int row_off, const float* mixv, LAS float* scr, int item, int lane) {
    const int nblk = N / 32, kb = item / nblk, nb = item % nblk, k0 = 64 * kb, n0 = 32 * nb;
#pragma unroll 8
    for (int i = 0; i < 32; ++i) { const int kk = 2 * i + (lane >> 5); scr[kk * 33 + (lane & 31)] = W[(size_t)(k0 + kk) * N + n0 + (lane & 31)]; }
    LDS_WAIT(); asm volatile("" ::: "memory");
    const int c = lane & 7;
    float mx[8];
#pragma unroll
    for (int i = 0; i < 8; ++i) mx[i] = (MODE == 3) ? mixv[k0 + 8 * c + i] : 0.f;
#pragma unroll
    for (int j = 0; j < 4; ++j) { const int n = (lane >> 3) + 8 * j; const LAS float* s = scr + (8 * c) * 33 + n;
        float v[8];
#pragma unroll
        for (int i = 0; i < 8; ++i) v[i] = s[i * 33];
        const int dr = (MODE == 3) ? (n0 + n) : dst_row<MODE>(n0 + n);
        bf16* drow = WT + (size_t)(row_off + dr) * ldd + k0 + 8 * c;
        if (MODE == 3) {
            v4u o; o.x = pk2(v[0] * (1.f - mx[0]), v[1] * (1.f - mx[1])); o.y = pk2(v[2] * (1.f - mx[2]), v[3] * (1.f - mx[3])); o.z = pk2(v[4] * (1.f - mx[4]), v[5] * (1.f - mx[5])); o.w = pk2(v[6] * (1.f - mx[6]), v[7] * (1.f - mx[7]));
            *(GAS v4u*)drow = o;
            v4u p; p.x = pk2(v[0] * mx[0], v[1] * mx[1]); p.y = pk2(v[2] * mx[2], v[3] * mx[3]); p.z = pk2(v[4] * mx[4], v[5] * mx[5]); p.w = pk2(v[6] * mx[6], v[7] * mx[7]);
            *(GAS v4u*)(drow + 1024) = p;
        } else { v4u o; o.x = pk2(v[0], v[1]); o.y = pk2(v[2], v[3]); o.z = pk2(v[4], v[5]); o.w = pk2(v[6], v[7]); *(GAS v4u*)drow = o; }
    }
    LDS_WAIT(); asm volatile("" ::: "memory");
}
__device__ __forceinline__ int fresh_tid() { int t = threadIdx.x; asm volatile("" : "+v"(t)); return t; }
__device__ __forceinline__ float wsum(float v) {
#pragma unroll
    for (int o = 1; o < 64; o <<= 1) v += __shfl_xor(v, o);
    return v;
}
__device__ __forceinline__ void p0_prologue(const Frame& F, const Args& a) {
    unsigned char* ws = a.ws; const int lane = fresh_tid() & 63;
    LAS float* scr = (LAS float*)(F.lds + RING_OFF + F.wave * 16384);
    const float* win = a.in[2]; const float* wout = a.in[3]; const float* mix = a.in[8]; const float* wrkv = a.in[9];
    constexpr int I_IN = (D / 64) * (2 * DFF / 32), I_OUT = (DFF / 64) * (D / 32), I_QKV = (D / 64) * (NQKV / 32), I_SQ = (D / 64) * (D / 32);
    constexpr int NITEMS = 4 * I_IN + 4 * I_OUT + I_QKV + 2 * I_SQ + 3 * I_SQ;
    for (int it = F.gw; it < NITEMS; it += F.NGW) {
        int r = it;
        if (r < 4 * I_IN) { const int q = r / I_IN; r -= q * I_IN;
            p0_transpose_item<1>(win + (size_t)q * D * 2 * DFF, D, 2 * DFF, (bf16*)(ws + (q < 2 ? WS_WIN0 : WS_WIN1) + (size_t)(q & 1) * SZ_WIN), D, 0, nullptr, scr, r, lane); continue; }
        r -= 4 * I_IN;
        if (r < 4 * I_OUT) { const int q = r / I_OUT; r -= q * I_OUT;
            p0_transpose_item<0>(wout + (size_t)q * DFF * D, DFF, D, (bf16*)(ws + (q < 2 ? WS_WOUT0 : WS_WOUT1) + (size_t)(q & 1) * SZ_WOUT), DFF, 0, nullptr, scr, r, lane); continue; }
        r -= 4 * I_OUT;
        if (r < I_QKV) { p0_transpose_item<2>(a.in[4], D, NQKV, (bf16*)(ws + WS_WQKV), D, 0, nullptr, scr, r, lane); continue; }
        r -= I_QKV;
        if (r < I_SQ) { p0_transpose_item<0>(a.in[7], D, D, (bf16*)(ws + WS_WOA), D, 0, nullptr, scr, r, lane); continue; }
        r -= I_SQ;
        if (r < I_SQ) { p0_transpose_item<0>(a.in[10], D, D, (bf16*)(ws + WS_WOR), D, 0, nullptr, scr, r, lane); continue; }
        r -= I_SQ;
        { const int z = r / I_SQ; r -= z * I_SQ; const int mi = (z == 0) ? 0 : (z == 1 ? 2 : 3);
          p0_transpose_item<3>(wrkv + (size_t)z * D * D, D, D, (bf16*)(ws + WS_W14), 2048, z * 1024, mix + mi * D, scr, r, lane); }
    }
    const int gt = F.gw * 64 + lane, NGT = F.NGW * 64;
    for (int e = gt; e < 512 * 2048 / 8; e += NGT) { const int n = e / 256, c8 = (e % 256) * 8;
        const float* W; int nn, ldw, mi; bool z = false;
        if (n < 64) { W = a.in[12]; nn = n; ldw = 64; mi = 1; } else if (n < 128) { W = a.in[15]; nn = n - 64; ldw = 64; mi = 4; } else if (n < 288) { W = a.in[17]; nn = n - 128; ldw = 160; mi = 5; } else { W = a.in[12]; nn = 0; ldw = 64; mi = 1; z = true; }
        float v[8];
#pragma unroll
        for (int i = 0; i < 8; ++i) { const int kf = c8 + i, k = kf & 1023; const float mv = mix[mi * D + k]; const float w = W[(size_t)k * ldw + nn]; v[i] = z ? 0.f : (kf < 1024 ? (1.f - mv) * w : mv * w); }
        v4u o; o.x = pk2(v[0], v[1]); o.y = pk2(v[2], v[3]); o.z = pk2(v[4], v[5]); o.w = pk2(v[6], v[7]);
        *(GAS v4u*)((bf16*)(ws + WS_W14) + (size_t)(3072 + n) * 2048 + c8) = o; }
    for (int e = gt; e < 3072 * 512 / 8; e += NGT) { const int n = e / 64, c8 = (e % 64) * 8, kind = n >> 10, nn = n & 1023;
        const float* W = kind == 0 ? a.in[13] : (kind == 1 ? a.in[16] : a.in[18]); const int lo = kind == 0 ? 0 : (kind == 1 ? 64 : 128), hi = kind == 0 ? 64 : (kind == 1 ? 128 : 288);
        float v[8];
#pragma unroll
        for (int i = 0; i < 8; ++i) { const int k = c8 + i; const bool in = (k >= lo && k < hi); v[i] = in ? W[(size_t)(in ? k - lo : 0) * D + nn] : 0.f; }
        v4u o; o.x = pk2(v[0], v[1]); o.y = pk2(v[2], v[3]); o.z = pk2(v[4], v[5]); o.w = pk2(v[6], v[7]);
        *(GAS v4u*)((bf16*)(ws + WS_W15) + (size_t)n * 512 + c8) = o; }
    for (int e = gt; e < SEQ * 32; e += NGT) { const int pos = e >> 5, d = e & 31; const float inv = powf(10000.f, -(float)(2 * d) / 64.f), ang = (float)pos * inv;
        ((float*)(ws + WS_ROPE))[e] = cosf(ang); ((float*)(ws + WS_ROPE))[SEQ * 32 + e] = sinf(ang); }
}

__device__ __forceinline__ void np_phase(const Frame& F, const float* base, const float* Fm, const float* gpost, const float* gpre, float* xo, bf16* XN, float scale, int mode) {
    const int lane = fresh_tid() & 63;
    for (int m = F.gw; m < M; m += F.NGW) {
        const GAS f32x4* br = (const GAS f32x4*)(base + (size_t)m * D) + lane;
        f32x4 v[4]; float s2 = 0.f;
        if (mode != 3) {
            const GAS f32x4* fr = (const GAS f32x4*)(Fm + (size_t)m * D) + lane;
            f32x4 f[4]; float ss = 0.f;
#pragma unroll
            for (int j = 0; j < 4; ++j) { f[j] = fr[64 * j]; v[j] = br[64 * j]; ss += (f[j].x * f[j].x + f[j].y * f[j].y) + (f[j].z * f[j].z + f[j].w * f[j].w); }
            const float r1 = rsqrtf(wsum(ss) * (1.f / D) + RMS_EPS) * scale;
            GAS f32x4* orow = (GAS f32x4*)(xo + (size_t)m * D) + lane;
#pragma unroll
            for (int j = 0; j < 4; ++j) { const f32x4 gp = ((const GAS f32x4*)gpost)[64 * j + lane]; v[j] = v[j] + (f[j] * r1) * gp; orow[64 * j] = v[j]; }
        } else {
#pragma unroll
            for (int j = 0; j < 4; ++j) v[j] = br[64 * j];
        }
        if (mode == 0) continue;
#pragma unroll
        for (int j = 0; j < 4; ++j) s2 += (v[j].x * v[j].x + v[j].y * v[j].y) + (v[j].z * v[j].z + v[j].w * v[j].w);
        const float r2 = rsqrtf(wsum(s2) * (1.f / D) + RMS_EPS);
#pragma unroll
        for (int j = 0; j < 4; ++j) { const f32x4 gq = ((const GAS f32x4*)gpre)[64 * j + lane]; const f32x4 o = (v[j] * r2) * gq;
            v2u w; w.x = pk2(o.x, o.y); w.y = pk2(o.z, o.w); const int c = 256 * j + 4 * lane;
            if (mode != 2) *(GAS v2u*)(XN + (size_t)m * D + c) = w;
            else { *(GAS v2u*)(XN + (size_t)m * 2048 + c) = w; if ((m & (SEQ - 1)) != SEQ - 1) *(GAS v2u*)(XN + (size_t)(m + 1) * 2048 + 1024 + c) = w;
                   if ((m & (SEQ - 1)) == 0) *(GAS v2u*)(XN + (size_t)m * 2048 + 1024 + c) = (v2u){0u, 0u}; } }
    }
}

__device__ __forceinline__ void attn_phase_simple(const Frame& F, const bf16* Q, const bf16* Kb, const bf16* Vb, const float* sinks, bf16* O) {
    LAS float* ps = (LAS float*)(F.lds + RING_OFF) + F.wave * 128; const int lane = fresh_tid() & 63;
    for (int task = F.gw; task < M * NH; task += F.NGW) {
        const int m = task >> 4, h = task & 15, hk = h >> 2, pos = m & (SEQ - 1);
        float s[2];
#pragma unroll
        for (int t = 0; t < 2; ++t) { const int off = lane + 64 * t; float acc = -INFINITY;
            if (pos - off >= 0) { acc = 0.f; const bf16* kr = Kb + (size_t)(m - off) * 256 + hk * 64; const bf16* qr = Q + (size_t)m * D + h * 64;
#pragma unroll
                for (int d = 0; d < 64; ++d) acc += bf2f(qr[d]) * bf2f(kr[d]);
                acc *= 0.125f; }
            s[t] = acc; }
        const float sink = sinks[h];
        float mx = fmaxf(s[0], s[1]);
#pragma unroll
        for (int o = 1; o < 64; o <<= 1) mx = fmaxf(mx, __shfl_xor(mx, o));
        mx = fmaxf(mx, sink);
        const float p0 = __expf(s[0] - mx), p1 = __expf(s[1] - mx);
        const float den = wsum(p0 + p1) + __expf(sink - mx);
        LDS_WAIT(); asm volatile("" ::: "memory");
        ps[lane] = p0 / den; ps[lane + 64] = p1 / den;
        LDS_WAIT(); asm volatile("" ::: "memory");
        float o = 0.f; const int nk = pos < 127 ? pos + 1 : 128;
        for (int off = 0; off < nk; ++off) o += ps[off] * bf2f(Vb[(size_t)(m - off) * 256 + hk * 64 + lane]);
        O[(size_t)m * D + h * 64 + lane] = f2bf(o);
    }
}

__device__ __forceinline__ void scan_phase_simple(const Frame& F, const bf16* R, const bf16* Kx, const bf16* V, const float* DEC, const bf16* ICL, const bf16* GB,
                                                  const float* k_k, const float* k_a, const float* r_k, const float* lnx_g, const float* lnx_b, bf16* Y) {
    if (F.wave != 0 || F.vcu >= BATCH * NH) return;
    LAS float* sv = (LAS float*)(F.lds + RING_OFF);
    const int lane = fresh_tid() & 63, b = F.vcu >> 4, h = F.vcu & 15, c = h * 64 + lane;
    LAS float* St = (LAS float*)(F.lds + RING_OFF + 2048) + lane;
#pragma unroll 1
    for (int j = 0; j < 64; ++j) St[64 * j] = 0.f;
    const float kk_c = k_k[c], ka_c = k_a[c], rk_c = r_k[c], lg = lnx_g[c], lb = lnx_b[c];
#pragma unroll 1
    for (int t = 0; t < SEQ; ++t) {
        const size_t o = (size_t)(b * SEQ + t) * D + c;
        const float r = bf2f(R[o]), k = bf2f(Kx[o]), v = bf2f(V[o]), w = DEC[o], ic = bf2f(ICL[o]), g = bf2f(GB[o]);
        float kk = k * kk_c; const float nrm = sqrtf(wsum(kk * kk)); kk = kk / fmaxf(nrm, 1e-12f);
        const float k2 = k * (1.f + (ic - 1.f) * ka_c);
        LDS_WAIT(); asm volatile("" ::: "memory");
        sv[0 * 64 + lane] = r; sv[1 * 64 + lane] = w; sv[2 * 64 + lane] = k2; sv[3 * 64 + lane] = -kk; sv[4 * 64 + lane] = kk * ic;
        LDS_WAIT(); asm volatile("" ::: "memory");
        float sa = 0.f;
#pragma unroll 4
        for (int j = 0; j < 64; ++j) sa += St[64 * j] * sv[3 * 64 + j];
        float y = 0.f;
#pragma unroll 4
        for (int j = 0; j < 64; ++j) { const float sn = St[64 * j] * sv[1 * 64 + j] + sa * sv[4 * 64 + j] + v * sv[2 * 64 + j]; St[64 * j] = sn; y += sn * sv[0 * 64 + j]; }
        const float mu = wsum(y) * (1.f / 64.f); const float dy = y - mu; const float var = wsum(dy * dy) * (1.f / 64.f);
        const float yn = dy * rsqrtf(var + LNX_EPS) * lg + lb;
        const float bonus = wsum(r * k2 * rk_c) * v;
        Y[o] = f2bf((yn + bonus) * g);
    }
}

#ifndef SP2
#define SP2 true
#endif
__global__ void __launch_bounds__(NWAVES * 64, 2) mega(Args args) {
    extern __shared__ __attribute__((aligned(16))) unsigned char lds[];
    Frame F;
    F.lds = (LAS unsigned char*)lds; F.MISC = (volatile LAS unsigned*)(F.lds + MISC_OFF);
    F.tid = threadIdx.x; F.lane = F.tid & 63; F.wave = __builtin_amdgcn_readfirstlane(F.tid >> 6);
    F.G = gridDim.x; { const int bx = blockIdx.x; F.vcu = (F.G % 8 == 0) ? (bx % 8) * (F.G / 8) + bx / 8 : bx; }
    F.gw = F.vcu * NWAVES + F.wave; F.NGW = F.G * NWAVES;
    unsigned char* ws = args.ws; F.ctl = (gu32*)(ws + WS_CTL);
    for (int u = F.tid; u < (LDS_BYTES - LDSCTL_OFF) / 4; u += NWAVES * 64) ((LAS unsigned*)(F.lds + LDSCTL_OFF))[u] = 0u;
    __syncthreads();
    const int lo = args.ph_lo, hi = args.ph_hi;
    XcdBarrier bar; bar.bar = (unsigned*)(F.ctl + CW_BAR) + args.li * XCD_BAR_WORDS; bar.x = 0; bar.st = nullptr;
    if (hi - lo > 1) bar = xcd_barrier_post((unsigned*)(F.ctl + CW_BAR) + args.li * XCD_BAR_WORDS, F.MISC + 8);
#ifndef PHASE_MASK
#define PHASE_MASK 0x3fffffull
#endif
#define IN(k) (((PHASE_MASK >> (k)) & 1ull) && lo <= (k) && (k) < hi)
#define SEAM(k) do { if (IN(k) && IN((k) + 1)) xcd_barrier(bar); } while (0)
    const float* x_in = args.in[0]; const float* ng = args.in[1]; float* out = args.out;
    bf16* XN = (bf16*)(ws + PS_XN); float* Fb = (float*)(ws + PS_F); bf16* HB = (bf16*)(ws + PS_HB);
    bf16* Qb = (bf16*)(ws + PS_Q); bf16* Kb = (bf16*)(ws + PS_K); bf16* Vb = (bf16*)(ws + PS_V); bf16* OB = (bf16*)(ws + PS_O);
    bf16* XN2 = (bf16*)(ws + PS_XN2); bf16* LH = (bf16*)(ws + PS_LH); float* DEC = (float*)(ws + PS_DEC);
    bf16* RKV = (bf16*)(ws + PS_RKV); bf16* ICL = (bf16*)(ws + PS_ICL); bf16* GB = (bf16*)(ws + PS_GB); bf16* YB = (bf16*)(ws + PS_YB);
    const float* cosT = (const float*)(ws + WS_ROPE); const float* sinT = cosT + SEQ * 32;
#define NG(l, i) (ng + (size_t)((l) * 6 + (i)) * D)
#define GEMM(EPI, E, Aptr, Bptr, NN, KK) do { pg8::Gemm g{(const pg8::bf16_t*)(Aptr), (const pg8::bf16_t*)(Bptr), M, (NN), (KK)}; pg8::StaticOrder S; S.init(M, (NN), F.G, (int)blockIdx.x); \
        pg8::gemm_phase<EPI, pg8::StaticOrder, true, SP2>(F.lds + RING_OFF, g, S, E); } while (0)
    if (IN(0)) { p0_prologue(F, args); np_phase(F, x_in, nullptr, nullptr, NG(0, 0), nullptr, XN, 1.f, 3); } SEAM(0);
    if (IN(1)) { pg8::EpiSwiglu E{HB}; GEMM(pg8::EpiSwiglu, E, XN, ws + WS_WIN0, 2 * DFF, D); } SEAM(1);
    if (IN(2)) { pg8::EpiF32 E{Fb, D}; GEMM(pg8::EpiF32, E, HB, ws + WS_WOUT0, D, DFF); } SEAM(2);
    if (IN(3)) np_phase(F, x_in, Fb, NG(0, 1), NG(0, 2), out, XN, 0.5f, 1); SEAM(3);
    if (IN(4)) { pg8::EpiQKV E{Qb, Kb, Vb, args.in[5], cosT, sinT}; GEMM(pg8::EpiQKV, E, XN, ws + WS_WQKV, NQKV, D); } SEAM(4);
    if (IN(5)) attn_phase_simple(F, Qb, Kb, Vb, args.in[6], OB); SEAM(5);
    if (IN(6)) { pg8::EpiF32 E{Fb, D}; GEMM(pg8::EpiF32, E, OB, ws + WS_WOA, D, D); } SEAM(6);
    if (IN(7)) np_phase(F, out, Fb, NG(0, 3), NG(0, 4), out, XN, 1.0f, 1); SEAM(7);
    if (IN(8)) { pg8::EpiSwiglu E{HB}; GEMM(pg8::EpiSwiglu, E, XN, ws + WS_WIN0 + SZ_WIN, 2 * DFF, D); } SEAM(8);
    if (IN(9)) { pg8::EpiF32 E{Fb, D}; GEMM(pg8::EpiF32, E, HB, ws + WS_WOUT0 + SZ_WOUT, D, DFF); } SEAM(9);
    if (IN(10)) np_phase(F, out, Fb, NG(0, 5), NG(1, 0), out, XN, 0.5f, 1); SEAM(10);
    if (IN(11)) { pg8::EpiSwiglu E{HB}; GEMM(pg8::EpiSwiglu, E, XN, ws + WS_WIN1, 2 * DFF, D); } SEAM(11);
    if (IN(12)) { pg8::EpiF32 E{Fb, D}; GEMM(pg8::EpiF32, E, HB, ws + WS_WOUT1, D, DFF); } SEAM(12);
    if (IN(13)) np_phase(F, out, Fb, NG(1, 1), NG(1, 2), out, XN2, 0.5f, 2); SEAM(13);
    if (IN(14)) { pg8::EpiRwkv1 E{RKV, LH}; GEMM(pg8::EpiRwkv1, E, XN2, ws + WS_W14, 3584, 2048); } SEAM(14);
    if (IN(15)) { pg8::EpiRwkv2 E{DEC, ICL, GB, args.in[11], args.in[14]}; GEMM(pg8::EpiRwkv2, E, LH, ws + WS_W15, 3072, 512); } SEAM(15);
    if (IN(16)) scan_phase_simple(F, RKV, RKV + (size_t)M * D, RKV + (size_t)2 * M * D, DEC, ICL, GB, args.in[19], args.in[20], args.in[21], args.in[22], args.in[23], YB); SEAM(16);
    if (IN(17)) { pg8::EpiF32 E{Fb, D}; GEMM(pg8::EpiF32, E, YB, ws + WS_WOR, D, D); } SEAM(17);
    if (IN(18)) np_phase(F, out, Fb, NG(1, 3), NG(1, 4), out, XN, 1.0f, 1); SEAM(18);
    if (IN(19)) { pg8::EpiSwiglu E{HB}; GEMM(pg8::EpiSwiglu, E, XN, ws + WS_WIN1 + SZ_WIN, 2 * DFF, D); } SEAM(19);
    if (IN(20)) { pg8::EpiF32 E{Fb, D}; GEMM(pg8::EpiF32, E, HB, ws + WS_WOUT1 + SZ_WOUT, D, DFF); } SEAM(20);
    if (IN(21)) np_phase(F, out, Fb, NG(1, 5), nullptr, out, XN, 0.5f, 0);
#undef IN
#undef SEAM
}

#ifndef NAIVE_MASK
#define NAIVE_MASK 0ull
#endif
#ifndef ONE_LAUNCH
#define ONE_LAUNCH 1
#endif
extern "C" void kernel_launch(void* const* d_in, const int* in_sizes, int n_in, void* d_out, int out_size, void* d_ws, size_t ws_size, hipStream_t stream) {
    static int grid = 0;
    if (grid == 0) {
        if (n_in != 24 || out_size != M * D || ws_size < PS_END) { fprintf(stderr, "kernel_launch: unexpected shapes n_in %d out %d ws %zu (need %zu)\n", n_in, out_size, ws_size, (size_t)PS_END); grid = -1; return; }
        int dev = 0, cus = 0, per_cu = 0;
        if (hipGetDevice(&dev) != hipSuccess || hipDeviceGetAttribute(&cus, hipDeviceAttributeMultiprocessorCount, dev) != hipSuccess) { grid = -1; return; }
        if (hipFuncSetAttribute((const void*)mega, hipFuncAttributeMaxDynamicSharedMemorySize, LDS_BYTES) != hipSuccess) { fprintf(stderr, "kernel_launch: hipFuncSetAttribute failed\n"); grid = -1; return; }
        if (hipOccupancyMaxActiveBlocksPerMultiprocessor(&per_cu, (const void*)mega, NWAVES * 64, LDS_BYTES) != hipSuccess || per_cu < 1) fprintf(stderr, "kernel_launch: occupancy query says %d\n", per_cu);
        (void)hipGetLastError();
        grid = cus;
    }
    if (grid < 0) return;
    const float* x = (const float*)d_in[0]; const float* ng = (const float*)d_in[1]; const float* win = (const float*)d_in[2]; const float* wout = (const float*)d_in[3];
    const float* wqkv = (const float*)d_in[4]; const float* bqkv = (const float*)d_in[5]; const float* sinks = (const float*)d_in[6]; const float* wo_a = (const float*)d_in[7];
    const float* mix = (const float*)d_in[8]; const float* wrkv = (const float*)d_in[9]; const float* wo_r = (const float*)d_in[10]; const float* w0 = (const float*)d_in[11];
    const float* w1 = (const float*)d_in[12]; const float* w2 = (const float*)d_in[13]; const float* a0 = (const float*)d_in[14]; const float* a1 = (const float*)d_in[15];
    const float* a2 = (const float*)d_in[16]; const float* g1 = (const float*)d_in[17]; const float* g2 = (const float*)d_in[18]; const float* k_k = (const float*)d_in[19];
    const float* k_a = (const float*)d_in[20]; const float* r_k = (const float*)d_in[21]; const float* lnx_g = (const float*)d_in[22]; const float* lnx_b = (const float*)d_in[23];
    float* out = (float*)d_out; unsigned char* ws = (unsigned char*)d_ws;
    bf16* XN = (bf16*)(ws + PS_XN); float* F = (float*)(ws + PS_F); bf16* HB = (bf16*)(ws + PS_HB);
    bf16* Q = (bf16*)(ws + PS_Q); bf16* Kb = (bf16*)(ws + PS_K); bf16* Vb = (bf16*)(ws + PS_V); bf16* OB = (bf16*)(ws + PS_O);
    bf16* XN2 = (bf16*)(ws + PS_XN2); bf16* LH = (bf16*)(ws + PS_LH); float* DEC = (float*)(ws + PS_DEC);
    bf16* RKV = (bf16*)(ws + PS_RKV); bf16* ICL = (bf16*)(ws + PS_ICL); bf16* GB = (bf16*)(ws + PS_GB); bf16* YB = (bf16*)(ws + PS_YB);
    const dim3 blk(256);
    auto G = [&](int l, int i) { return ng + (size_t)(l * 6 + i) * D; };
    auto n_swiglu = [&](int l, int f) { OpSwiglu o{XN, win + (size_t)(l * 2 + f) * D * 2 * DFF, HB, D, 2 * DFF, DFF, 0}; hipLaunchKernelGGL(ngemm<OpSwiglu>, dim3(DFF / 64, M / 64), blk, 0, stream, o); };
    auto n_out = [&](int l, int f) { OpF32 o{HB, wout + (size_t)(l * 2 + f) * DFF * D, F, DFF, D, D, DFF}; hipLaunchKernelGGL(ngemm<OpF32>, dim3(D / 64, M / 64), blk, 0, stream, o); };
    auto n_np = [&](const float* base, const float* gpost, const float* gpre, bf16* xn, float scale, int mode) { hipLaunchKernelGGL(k_np, dim3(M / 4), blk, 0, stream, base, (const float*)F, gpost, gpre, out, xn, scale, mode); };
    auto naive_phase = [&](int p) {
        switch (p) {
        case 0: hipLaunchKernelGGL(k_prenorm, dim3(M / 4), blk, 0, stream, x, G(0, 0), XN); break;
        case 1: n_swiglu(0, 0); break;
        case 2: n_out(0, 0); break;
        case 3: n_np(x, G(0, 1), G(0, 2), XN, 0.5f, 1); break;
        case 4: { OpQKrope o{XN, wqkv, bqkv, Q, Kb, D, NQKV, 640, 0}; hipLaunchKernelGGL(ngemm<OpQKrope>, dim3(10, M / 64), blk, 0, stream, o);
                  OpV ov{XN, wqkv, bqkv, Vb, D, NQKV, 256, 0}; hipLaunchKernelGGL(ngemm<OpV>, dim3(4, M / 64), blk, 0, stream, ov); } break;
        case 5: hipLaunchKernelGGL(k_attn, dim3(M * NH / 4), blk, 0, stream, (const bf16*)Q, (const bf16*)Kb, (const bf16*)Vb, sinks, OB); break;
        case 6: { OpF32 o{OB, wo_a, F, D, D, D, D}; hipLaunchKernelGGL(ngemm<OpF32>, dim3(D / 64, M / 64), blk, 0, stream, o); } break;
        case 7: n_np(out, G(0, 3), G(0, 4), XN, 1.0f, 1); break;
        case 8: n_swiglu(0, 1); break;
        case 9: n_out(0, 1); break;
        case 10: n_np(out, G(0, 5), G(1, 0), XN, 0.5f, 1); break;
        case 11: n_swiglu(1, 0); break;
        case 12: n_out(1, 0); break;
        case 13: n_np(out, G(1, 1), G(1, 2), XN2, 0.5f, 2); break;
        case 14: { for (int z = 0; z < 3; ++z) { const int mi = (z == 0) ? 0 : (z == 1 ? 2 : 3);
                       OpRwkvProj o{XN2, mix + mi * D, wrkv + (size_t)z * D * D, RKV + (size_t)z * M * D, D, D, D, D, 0, 0}; hipLaunchKernelGGL(ngemm<OpRwkvProj>, dim3(D / 64, M / 64), blk, 0, stream, o); }
                   OpRwkvProj ow{XN2, mix + 1 * D, w1, LH, D, 64, 64, 512, 1, 0};        hipLaunchKernelGGL(ngemm<OpRwkvProj>, dim3(1, M / 64), blk, 0, stream, ow);
                   OpRwkvProj oa{XN2, mix + 4 * D, a1, LH + 64, D, 64, 64, 512, 0, 0};   hipLaunchKernelGGL(ngemm<OpRwkvProj>, dim3(1, M / 64), blk, 0, stream, oa);
                   OpRwkvProj og{XN2, mix + 5 * D, g1, LH + 128, D, 160, 160, 512, 2, 0}; hipLaunchKernelGGL(ngemm<OpRwkvProj>, dim3(3, M / 64), blk, 0, stream, og); } break;
        case 15: { OpLoraUp ow{LH, w2, w0, DEC, nullptr, 64, D, D, 512, 0, 0};        hipLaunchKernelGGL(ngemm<OpLoraUp>, dim3(D / 64, M / 64), blk, 0, stream, ow);
                   OpLoraUp oa{LH + 64, a2, a0, nullptr, ICL, 64, D, D, 512, 1, 0};   hipLaunchKernelGGL(ngemm<OpLoraUp>, dim3(D / 64, M / 64), blk, 0, stream, oa);
                   OpLoraUp og{LH + 128, g2, nullptr, nullptr, GB, 160, D, D, 512, 2, 0}; hipLaunchKernelGGL(ngemm<OpLoraUp>, dim3(D / 64, M / 64), blk, 0, stream, og); } break;
        case 16: hipLaunchKernelGGL(k_scan, dim3(BATCH * NH), dim3(64), 0, stream, (const bf16*)RKV, (const bf16*)(RKV + (size_t)M * D), (const bf16*)(RKV + (size_t)2 * M * D), (const float*)DEC,
                                    (const bf16*)ICL, (const bf16*)GB, k_k, k_a, r_k, lnx_g, lnx_b, YB); break;
        case 17: { OpF32 o{YB, wo_r, F, D, D, D, D}; hipLaunchKernelGGL(ngemm<OpF32>, dim3(D / 64, M / 64), blk, 0, stream, o); } break;
        case 18: n_np(out, G(1, 3), G(1, 4), XN, 1.0f, 1); break;
        case 19: n_swiglu(1, 1); break;
        case 20: n_out(1, 1); break;
        case 21: n_np(out, G(1, 5), nullptr, XN, 0.5f, 0); break;
        }
    };
    (void)hipMemsetAsync((char*)d_ws + WS_CTL, 0, CTL_ZERO_BYTES, stream);
    Args a{};
    for (int i = 0; i < 24; ++i) a.in[i] = (const float*)d_in[i];
    a.out = out; a.ws = ws;
    const unsigned long long nmask = NAIVE_MASK;
    int li = 0;
    for (int p = 0; p < N_PHASES;) {
        if ((nmask >> p) & 1ull) { naive_phase(p); ++p; continue; }
        int q = p + 1;
        if (ONE_LAUNCH) while (q < N_PHASES && !((nmask >> q) & 1ull)) ++q;
        a.ph_lo = p; a.ph_hi = q; a.li = li++;
        hipLaunchKernelGGL(mega, dim3(grid), dim3(NWAVES * 64), LDS_BYTES, stream, a);
        p = q;
    }
}
```

```cpp
#include <hip/hip_runtime.h>
#include <cstdio>
#include <cstdint>
#include <cmath>

typedef unsigned short bf16;
__device__ __forceinline__ float bf2f(bf16 v) { return __uint_as_float(((unsigned)v) << 16); }
__device__ __forceinline__ bf16 f2bf(float f) { unsigned u = __float_as_uint(f); return (bf16)((u + 0x7fffu + ((u >> 16) & 1u)) >> 16); }

constexpr int BATCH = 4, SEQ = 4096, D = 1024, M = BATCH * SEQ, DFF = 2816, NQKV = 1536, NH = 16, NKV = 4, HD = 64, WIN = 128;
constexpr float RMS_EPS = 1e-6f, LNX_EPS = 64e-5f;

template <class Op>
__global__ void __launch_bounds__(256) ngemm(Op op) {
    __shared__ float As[16][65];
    __shared__ float W1[16][65];
    __shared__ float W2[16][65];
    const int tx = threadIdx.x & 15, ty = threadIdx.x >> 4;
    const int m0 = blockIdx.y * 64, n0 = blockIdx.x * 64;
    float a1[4][4], a2[4][4];
#pragma unroll
    for (int i = 0; i < 4; ++i)
#pragma unroll
        for (int j = 0; j < 4; ++j) { a1[i][j] = 0.f; a2[i][j] = 0.f; }
    for (int k0 = 0; k0 < op.K; k0 += 16) {
#pragma unroll
        for (int e = 0; e < 4; ++e) { const int idx = threadIdx.x * 4 + e, r = idx >> 4, kk = idx & 15; As[kk][r] = op.loadA(m0 + r, k0 + kk); }
#pragma unroll
        for (int e = 0; e < 4; ++e) { const int idx = threadIdx.x + e * 256, kk = idx >> 6, n = idx & 63, gn = n0 + n;
            W1[kk][n] = gn < op.npairs ? op.W[(size_t)(k0 + kk) * op.ldw + op.col1(gn)] : 0.f;
            if (Op::DUAL) W2[kk][n] = gn < op.npairs ? op.W[(size_t)(k0 + kk) * op.ldw + op.col2(gn)] : 0.f; }
        __syncthreads();
#pragma unroll
        for (int kk = 0; kk < 16; ++kk) {
            float av[4], wv[4], wv2[4];
#pragma unroll
            for (int i = 0; i < 4; ++i) av[i] = As[kk][ty * 4 + i];
#pragma unroll
            for (int j = 0; j < 4; ++j) { wv[j] = W1[kk][tx * 4 + j]; wv2[j] = Op::DUAL ? W2[kk][tx * 4 + j] : 0.f; }
#pragma unroll
            for (int i = 0; i < 4; ++i)
#pragma unroll
                for (int j = 0; j < 4; ++j) { a1[i][j] += av[i] * wv[j]; if (Op::DUAL) a2[i][j] += av[i] * wv2[j]; }
        }
        __syncthreads();
    }
#pragma unroll
    for (int i = 0; i < 4; ++i)
#pragma unroll
        for (int j = 0; j < 4; ++j) { const int m = m0 + ty * 4 + i, n = n0 + tx * 4 + j; if (n < op.npairs) op.store(m, n, a1[i][j], a2[i][j]); }
}

struct OpSwiglu {
    static constexpr bool DUAL = true;
    const bf16* A; const float* W; bf16* O; int K, ldw, npairs, pad;
    __device__ float loadA(int m, int k) const { return bf2f(A[(size_t)m * D + k]); }
    __device__ int col1(int n) const { return n; }
    __device__ int col2(int n) const { return DFF + n; }
    __device__ void store(int m, int n, float g, float u) const { const float s = g / (1.f + expf(-g)); O[(size_t)m * DFF + n] = f2bf(s * u); }
};
struct OpF32 {
    static constexpr bool DUAL = false;
    const bf16* A; const float* W; float* O; int K, ldw, npairs, lda;
    __device__ float loadA(int m, int k) const { return bf2f(A[(size_t)m * lda + k]); }
    __device__ int col1(int n) const { return n; }
    __device__ int col2(int n) const { return n; }
    __device__ void store(int m, int n, float a, float) const { O[(size_t)m * npairs + n] = a; }
};
struct OpQKrope {
    static constexpr bool DUAL = true;
    const bf16* A; const float* W; const float* bias; bf16* Q; bf16* Kb; int K, ldw, npairs, pad;
    __device__ float loadA(int m, int k) const { return bf2f(A[(size_t)m * D + k]); }
    __device__ int col1(int n) const { return (n >> 5) * 64 + (n & 31); }
    __device__ int col2(int n) const { return (n >> 5) * 64 + (n & 31) + 32; }
    __device__ void store(int m, int n, float a, float b) const {
        const int hh = n >> 5, d = n & 31, c1 = hh * 64 + d;
        const float x1 = a + bias[c1], x2 = b + bias[c1 + 32];
        const float pos = (float)(m % SEQ), inv = powf(10000.f, -(float)(2 * d) / 64.f), ang = pos * inv;
        const float cs = cosf(ang), sn = sinf(ang);
        const float o1 = x1 * cs - x2 * sn, o2 = x2 * cs + x1 * sn;
        if (hh < 16) { Q[(size_t)m * D + hh * 64 + d] = f2bf(o1); Q[(size_t)m * D + hh * 64 + d + 32] = f2bf(o2); }
        else { Kb[(size_t)m * 256 + (hh - 16) * 64 + d] = f2bf(o1); Kb[(size_t)m * 256 + (hh - 16) * 64 + d + 32] = f2bf(o2); }
    }
};
struct OpV {
    static constexpr bool DUAL = false;
    const bf16* A; const float* W; const float* bias; bf16* V; int K, ldw, npairs, pad;
    __device__ float loadA(int m, int k) const { return bf2f(A[(size_t)m * D + k]); }
    __device__ int col1(int n) const { return 1280 + n; }
    __device__ int col2(int n) const { return 1280 + n; }
    __device__ void store(int m, int n, float a, float) const { V[(size_t)m * 256 + n] = f2bf(a + bias[1280 + n]); }
};
struct OpRwkvProj {
    static constexpr bool DUAL = false;
    const bf16* XN2; const float* mix; const float* W; bf16* O; int K, ldw, npairs, ldo, act, pad;
    __device__ float loadA(int m, int k) const { const float h = bf2f(XN2[(size_t)m * 2048 + k]), p = bf2f(XN2[(size_t)m * 2048 + 1024 + k]); return h + (p - h) * mix[k]; }
    __device__ int col1(int n) const { return n; }
    __device__ int col2(int n) const { return n; }
    __device__ void store(int m, int n, float a, float) const { float v = a; if (act == 1) v = tanhf(a); else if (act == 2) v = 1.f / (1.f + expf(-a)); O[(size_t)m * ldo + n] = f2bf(v); }
};
struct OpLoraUp {
    static constexpr bool DUAL = false;
    const bf16* A; const float* W; const float* add; float* Of; bf16* Ob; int K, ldw, npairs, lda, kind, pad;
    __device__ float loadA(int m, int k) const { return bf2f(A[(size_t)m * lda + k]); }
    __device__ int col1(int n) const { return n; }
    __device__ int col2(int n) const { return n; }
    __device__ void store(int m, int n, float a, float) const {
        if (kind == 0) { const float x = add[n] + a; const float sp = (x > 20.f) ? 0.f : log1pf(expf(-x));
            const float logw = -sp - 0.5f; Of[(size_t)m * D + n] = expf(-expf(logw)); }
        else if (kind == 1) { const float x = add[n] + a; Ob[(size_t)m * D + n] = f2bf(1.f / (1.f + expf(-x))); }
        else Ob[(size_t)m * D + n] = f2bf(a);
    }
};

__device__ __forceinline__ float wave_sum(float v) {
#pragma unroll
    for (int o = 1; o < 64; o <<= 1) v += __shfl_xor(v, o);
    return v;
}
__global__ void __launch_bounds__(256) k_prenorm(const float* x, const float* g, bf16* XN) {
    const int lane = threadIdx.x & 63, m = blockIdx.x * 4 + (threadIdx.x >> 6);
    float v[16]; float ss = 0.f;
#pragma unroll
    for (int j = 0; j < 16; ++j) { v[j] = x[(size_t)m * D + j * 64 + lane]; ss += v[j] * v[j]; }
    const float r = rsqrtf(wave_sum(ss) * (1.f / D) + RMS_EPS);
#pragma unroll
    for (int j = 0; j < 16; ++j) XN[(size_t)m * D + j * 64 + lane] = f2bf(v[j] * r * g[j * 64 + lane]);
}
__global__ void __launch_bounds__(256) k_np(const float* base, const float* F, const float* gpost, const float* gpre, float* xo, bf16* XN, float scale, int mode) {
    const int lane = threadIdx.x & 63, m = blockIdx.x * 4 + (threadIdx.x >> 6);
    float f[16], v[16]; float ss = 0.f;
#pragma unroll
    for (int j = 0; j < 16; ++j) { f[j] = F[(size_t)m * D + j * 64 + lane]; ss += f[j] * f[j]; }
    const float r1 = rsqrtf(wave_sum(ss) * (1.f / D) + RMS_EPS);
    float s2 = 0.f;
#pragma unroll
    for (int j = 0; j < 16; ++j) { const int c = j * 64 + lane; v[j] = base[(size_t)m * D + c] + scale * (f[j] * r1 * gpost[c]); s2 += v[j] * v[j]; xo[(size_t)m * D + c] = v[j]; }
    if (mode == 0) return;
    const float r2 = rsqrtf(wave_sum(s2) * (1.f / D) + RMS_EPS);
#pragma unroll
    for (int j = 0; j < 16; ++j) { const int c = j * 64 + lane; const bf16 o = f2bf(v[j] * r2 * gpre[c]);
        if (mode == 1) XN[(size_t)m * D + c] = o;
        else { XN[(size_t)m * 2048 + c] = o; if ((m % SEQ) != SEQ - 1) XN[(size_t)(m + 1) * 2048 + 1024 + c] = o; if ((m % SEQ) == 0) XN[(size_t)m * 2048 + 1024 + c] = 0; } }
}

__global__ void __launch_bounds__(256) k_attn(const bf16* Q, const bf16* Kb, const bf16* Vb, const float* sinks, bf16* O) {
    __shared__ float ps[4][128];
    const int lane = threadIdx.x & 63, w = threadIdx.x >> 6, gw = blockIdx.x * 4 + w;
    const int m = gw >> 4, h = gw & 15, hk = h >> 2, pos = m % SEQ;
    float q[64];
#pragma unroll
    for (int d = 0; d < 64; ++d) q[d] = bf2f(Q[(size_t)m * D + h * 64 + d]);
    float s[2];
#pragma unroll
    for (int t = 0; t < 2; ++t) { const int off = lane + 64 * t;
        const int kp = pos - off; float acc = -INFINITY;
        if (kp >= 0) { acc = 0.f; const bf16* kr = Kb + (size_t)(m - off) * 256 + hk * 64;
#pragma unroll
            for (int d = 0; d < 64; ++d) acc += q[d] * bf2f(kr[d]);
            acc *= 0.125f; }
        s[t] = acc; }
    const float sink = sinks[h];
    float mx = fmaxf(s[0], s[1]);
#pragma unroll
    for (int o = 1; o < 64; o <<= 1) mx = fmaxf(mx, __shfl_xor(mx, o));
    mx = fmaxf(mx, sink);
    const float p0 = expf(s[0] - mx), p1 = expf(s[1] - mx);
    const float den = wave_sum(p0 + p1) + expf(sink - mx);
    ps[w][lane] = p0 / den; ps[w][lane + 64] = p1 / den;
    __syncthreads();
    float o = 0.f;
    for (int off = 0; off < 128; ++off) { if (pos - off < 0) break; o += ps[w][off] * bf2f(Vb[(size_t)(m - off) * 256 + hk * 64 + lane]); }
    O[(size_t)m * D + h * 64 + lane] = f2bf(o);
}

__global__ void __launch_bounds__(64) k_scan(const bf16* R, const bf16* Kx, const bf16* V, const float* DEC, const bf16* ICL, const bf16* GB,
                                            const float* k_k, const float* k_a, const float* r_k, const float* lnx_g, const float* lnx_b, bf16* Y) {
    __shared__ float sv[5][64];
    const int lane = threadIdx.x, b = blockIdx.x >> 4, h = blockIdx.x & 15, c = h * 64 + lane;
    float S[64];
#pragma unroll
    for (int j = 0; j < 64; ++j) S[j] = 0.f;
    const float kk_c = k_k[c], ka_c = k_a[c], rk_c = r_k[c], lg = lnx_g[c], lb = lnx_b[c];
    for (int t = 0; t < SEQ; ++t) {
        const size_t o = (size_t)(b * SEQ + t) * D + c;
        const float r = bf2f(R[o]), k = bf2f(Kx[o]), v = bf2f(V[o]), w = DEC[o], ic = bf2f(ICL[o]), g = bf2f(GB[o]);
        float kk = k * kk_c; const float nrm = sqrtf(wave_sum(kk * kk)); kk = kk / fmaxf(nrm, 1e-12f);
        const float k2 = k * (1.f + (ic - 1.f) * ka_c);
        __syncthreads();
        sv[0][lane] = r; sv[1][lane] = w; sv[2][lane] = k2; sv[3][lane] = -kk; sv[4][lane] = kk * ic;
        __syncthreads();
        float sa = 0.f;
#pragma unroll
        for (int j = 0; j < 64; ++j) sa += S[j] * sv[3][j];
        float y = 0.f;
#pragma unroll
        for (int j = 0; j < 64; ++j) { S[j] = S[j] * sv[1][j] + sa * sv[4][j] + v * sv[2][j]; y += S[j] * sv[0][j]; }
        const float mu = wave_sum(y) * (1.f / 64.f); const float dy = y - mu; const float var = wave_sum(dy * dy) * (1.f / 64.f);
        const float yn = dy * rsqrtf(var + LNX_EPS) * lg + lb;
        const float bonus = wave_sum(r * k2 * rk_c) * v;
        Y[o] = f2bf((yn + bonus) * g);
    }
}

constexpr size_t MiB = 1u << 20;
namespace pg8 {
#define PG8_LAS __attribute__((address_space(3)))
typedef unsigned short bf16_t;
typedef short bf16x8 __attribute__((ext_vector_type(8)));
typedef float f32x4 __attribute__((ext_vector_type(4)));
typedef unsigned u32x4 __attribute__((ext_vector_type(4)));
constexpr int BM = 256, BK = 64, HALF = 128, HTB = HALF * BK * 2  , STAGE_BYTES = 8 * HTB, NXCD = 8, WGM = 8;

__host__ __device__ __forceinline__ int lds_byte(int r, int c) { const int st = (r >> 4) * 2 + (c >> 5), rr = r & 15, cc = c & 31, ob = rr * 64 + cc * 2; return st * 1024 + (ob ^ (((ob >> 9) & 1) << 5)); }
__host__ __device__ __forceinline__ void stage_rc(int b, int& R, int& C) { const int st = b / 1024, sb = b % 1024, swz = sb ^ (((sb >> 9) & 1) << 5); R = (st >> 1) * 16 + swz / 64; C = (st & 1) * 32 + (swz % 64) / 2; }
__host__ __device__ __forceinline__ int perm32(int rho) { const int n = rho >> 4, i = rho & 15; return 8 * (i >> 2) + 4 * n + (i & 3); }

struct Unit { int pm, pn; };
struct Gemm { const bf16_t* A; const bf16_t* Bt; int M, N, K; };

struct StaticOrder {
    int nM, nN, nwg, G, c;
    __host__ __device__ void init(int M, int N, int G_, int c_) { nM = M / BM; nN = N / BM; nwg = nM * nN; G = G_; c = c_; }
    __host__ __device__ bool next(int i, Unit& u) const {
        const long L = (long)i * G + c; if (L >= nwg) return false;
        int wgid = (int)L; { const int q = nwg / NXCD, r = nwg % NXCD, xcd = wgid % NXCD, off = wgid / NXCD; wgid = (xcd < r ? xcd * (q + 1) : r * (q + 1) + (xcd - r) * q) + off; }
        const int nig = WGM * nN, gid = wgid / nig, fm = gid * WGM, gsz = (nM - fm) < WGM ? (nM - fm) : WGM;
        u.pm = fm + ((wgid % nig) % gsz); u.pn = (wgid % nig) / gsz; return true;
    }
    __device__ __forceinline__ void a_ready(const Unit&) const {}
    __device__ __forceinline__ void done(const Unit&) const {}
};


__device__ __forceinline__ unsigned cvt_pk_bf16(float lo, float hi) { unsigned r; asm volatile("v_cvt_pk_bf16_f32 %0, %1, %2" : "=v"(r) : "v"(lo), "v"(hi)); return r; }
typedef unsigned u32x2 __attribute__((ext_vector_type(2)));
__device__ __forceinline__ float fsigmoid(float x) { return __builtin_amdgcn_rcpf(1.f + __builtin_amdgcn_exp2f(-1.4426950408889634f * x)); }
__device__ __forceinline__ float ftanh(float x) { return 1.f - 2.f * __builtin_amdgcn_rcpf(1.f + __builtin_amdgcn_exp2f(2.885390081777927f * x)); }
__device__ __forceinline__ float swi(float g, float u) { return g * fsigmoid(g) * u; }

struct EpiSwiglu {
    static constexpr bool PERM = true, AFTER_DRAIN = false;
    bf16_t* O;
    __device__ __forceinline__ void operator()(const f32x4 (&acc)[2][2][4][2], const Unit& u, int wr, int wc, int fr, int fq) const {
        const int row0 = u.pm * BM + wr * 64 + fr, col0 = u.pn * 128 + wc * 32 + 8 * fq;
#pragma unroll
        for (int ai = 0; ai < 2; ++ai)
#pragma unroll
            for (int m = 0; m < 4; ++m) { bf16_t* rowp = O + (size_t)(row0 + ai * HALF + m * 16) * DFF + col0;
                const f32x4 g0 = acc[ai][0][m][0], g1 = acc[ai][0][m][1], u0 = acc[ai][1][m][0], u1 = acc[ai][1][m][1];
                u32x4 w; w.x = cvt_pk_bf16(swi(g0[0], u0[0]), swi(g0[1], u0[1])); w.y = cvt_pk_bf16(swi(g0[2], u0[2]), swi(g0[3], u0[3]));
                w.z = cvt_pk_bf16(swi(g1[0], u1[0]), swi(g1[1], u1[1])); w.w = cvt_pk_bf16(swi(g1[2], u1[2]), swi(g1[3], u1[3]));
                *(u32x4*)rowp = w; }
    }
};
struct EpiF32 {
    static constexpr bool PERM = false, AFTER_DRAIN = false;
    float* C; int ldc;
    __device__ __forceinline__ void operator()(const f32x4 (&acc)[2][2][4][2], const Unit& u, int wr, int wc, int fr, int fq) const {
        const int row0 = u.pm * BM + wr * 64 + fr, col0 = u.pn * BM + wc * 32 + 4 * fq;
#pragma unroll
        for (int ai = 0; ai < 2; ++ai)
#pragma unroll
            for (int m = 0; m < 4; ++m) { float* rowp = C + (size_t)(row0 + ai * HALF + m * 16) * ldc + col0;
#pragma unroll
                for (int bj = 0; bj < 2; ++bj)
#pragma unroll
                    for (int n = 0; n < 2; ++n) *(f32x4*)(rowp + bj * HALF + n * 16) = acc[ai][bj][m][n]; }
    }
};
struct EpiQKV {
    static constexpr bool PERM = true, AFTER_DRAIN = false;
    bf16_t* Q; bf16_t* Kb; bf16_t* Vb; const float* bias; const float* cosT; const float* sinT;
    __device__ __forceinline__ void operator()(const f32x4 (&acc)[2][2][4][2], const Unit& u, int wr, int wc, int fr, int fq) const {
        const int row0 = u.pm * BM + wr * 64 + fr, g = 4 * (wc & 1) + fq;
#pragma unroll
        for (int bj = 0; bj < 2; ++bj) {
            const int head = 4 * u.pn + 2 * bj + (wc >> 1), pc = head * 64 + 4 * g;
            const f32x4 b1 = *(const f32x4*)(bias + pc), b2 = *(const f32x4*)(bias + pc + 32);
            bf16_t* dst; int pitch;
            if (head < 16) { dst = Q + head * 64 + 4 * g; pitch = D; } else if (head < 20) { dst = Kb + (head - 16) * 64 + 4 * g; pitch = 256; } else { dst = Vb + (head - 20) * 64 + 4 * g; pitch = 256; }
#pragma unroll
            for (int ai = 0; ai < 2; ++ai)
#pragma unroll
                for (int m = 0; m < 4; ++m) { const int row = row0 + ai * HALF + m * 16;
                    f32x4 x1 = acc[ai][bj][m][0] + b1, x2 = acc[ai][bj][m][1] + b2;
                    if (head < 20) { const int pos = row & (SEQ - 1); const f32x4 cs = *(const f32x4*)(cosT + pos * 32 + 4 * g), sn = *(const f32x4*)(sinT + pos * 32 + 4 * g);
                        const f32x4 o1 = x1 * cs - x2 * sn, o2 = x2 * cs + x1 * sn; x1 = o1; x2 = o2; }
                    u32x2 w1, w2; w1.x = cvt_pk_bf16(x1[0], x1[1]); w1.y = cvt_pk_bf16(x1[2], x1[3]); w2.x = cvt_pk_bf16(x2[0], x2[1]); w2.y = cvt_pk_bf16(x2[2], x2[3]);
                    *(u32x2*)(dst + (size_t)row * pitch) = w1; *(u32x2*)(dst + (size_t)row * pitch + 32) = w2; }
        }
    }
};
struct EpiRwkv1 {
    static constexpr bool PERM = true, AFTER_DRAIN = false;
    bf16_t* RKV; bf16_t* LH;
    __device__ __forceinline__ void operator()(const f32x4 (&acc)[2][2][4][2], const Unit& u, int wr, int wc, int fr, int fq) const {
        const int row0 = u.pm * BM + wr * 64 + fr;
        if (u.pn < 12) {
            bf16_t* O = RKV + (size_t)(u.pn >> 2) * M * D; const int col0 = (u.pn & 3) * 256 + wc * 32 + 8 * fq;
#pragma unroll
            for (int ai = 0; ai < 2; ++ai)
#pragma unroll
                for (int m = 0; m < 4; ++m) { bf16_t* rowp = O + (size_t)(row0 + ai * HALF + m * 16) * D + col0;
#pragma unroll
                    for (int bj = 0; bj < 2; ++bj) { const f32x4 v0 = acc[ai][bj][m][0], v1 = acc[ai][bj][m][1];
                        u32x4 w; w.x = cvt_pk_bf16(v0[0], v0[1]); w.y = cvt_pk_bf16(v0[2], v0[3]); w.z = cvt_pk_bf16(v1[0], v1[1]); w.w = cvt_pk_bf16(v1[2], v1[3]);
                        *(u32x4*)(rowp + bj * HALF) = w; } }
        } else {
#pragma unroll
            for (int bj = 0; bj < 2; ++bj) { const int vc = (u.pn - 12) * 256 + bj * HALF + wc * 32 + 8 * fq; const int kind = vc < 64 ? 1 : (vc < 128 ? 0 : (vc < 288 ? 2 : 3));
#pragma unroll
                for (int ai = 0; ai < 2; ++ai)
#pragma unroll
                    for (int m = 0; m < 4; ++m) { f32x4 v0 = acc[ai][bj][m][0], v1 = acc[ai][bj][m][1];
#pragma unroll
                        for (int e = 0; e < 4; ++e) { if (kind == 1) { v0[e] = ftanh(v0[e]); v1[e] = ftanh(v1[e]); } else if (kind == 2) { v0[e] = fsigmoid(v0[e]); v1[e] = fsigmoid(v1[e]); } else if (kind == 3) { v0[e] = 0.f; v1[e] = 0.f; } }
                        u32x4 w; w.x = cvt_pk_bf16(v0[0], v0[1]); w.y = cvt_pk_bf16(v0[2], v0[3]); w.z = cvt_pk_bf16(v1[0], v1[1]); w.w = cvt_pk_bf16(v1[2], v1[3]);
                        *(u32x4*)(LH + (size_t)(row0 + ai * HALF + m * 16) * 512 + vc) = w; } }
        }
    }
};
struct EpiRwkv2 {
    static constexpr bool PERM = false, AFTER_DRAIN = false;
    float* DEC; bf16_t* ICL; bf16_t* GB; const float* w0; const float* a0;
    template <int KIND> __device__ __forceinline__ void run(const f32x4 (&acc)[2][2][4][2], int row0, int col0) const {
#pragma unroll
        for (int bj = 0; bj < 2; ++bj)
#pragma unroll
            for (int n = 0; n < 2; ++n) { const int col = col0 + bj * HALF + n * 16;
                f32x4 add = (f32x4){0.f, 0.f, 0.f, 0.f}; if (KIND == 0) add = *(const f32x4*)(w0 + col); if (KIND == 1) add = *(const f32x4*)(a0 + col);
#pragma unroll
                for (int ai = 0; ai < 2; ++ai)
#pragma unroll
                    for (int m = 0; m < 4; ++m) { const size_t off = (size_t)(row0 + ai * HALF + m * 16) * D + col; f32x4 x = acc[ai][bj][m][n] + add;
                        if (KIND == 0) { f32x4 o;
#pragma unroll
                            for (int e = 0; e < 4; ++e) o[e] = __builtin_amdgcn_exp2f(-0.6065306597f * 1.4426950408889634f * fsigmoid(x[e]));
                            *(f32x4*)(DEC + off) = o; }
                        else { if (KIND == 1) {
#pragma unroll
                                for (int e = 0; e < 4; ++e) x[e] = fsigmoid(x[e]); }
                            u32x2 w; w.x = cvt_pk_bf16(x[0], x[1]); w.y = cvt_pk_bf16(x[2], x[3]);
                            if (KIND == 1) *(u32x2*)(ICL + off) = w; else *(u32x2*)(GB + off) = w; } } }
    }
    __device__ __forceinline__ void operator()(const f32x4 (&acc)[2][2][4][2], const Unit& u, int wr, int wc, int fr, int fq) const {
        const int row0 = u.pm * BM + wr * 64 + fr, kind = u.pn >> 2, col0 = (u.pn & 3) * 256 + wc * 32 + 4 * fq;
        if (kind == 0) run<0>(acc, row0, col0); else if (kind == 1) run<1>(acc, row0, col0); else run<2>(acc, row0, col0);
    }
};
template <class Epi, class Sched, bool ALIGN_EPI = false, bool SP2 = false>
__device__ __forceinline__ void gemm_phase(PG8_LAS unsigned char* lds, const Gemm g, const Sched& S, const Epi& E) {
    int tid_ = threadIdx.x; asm volatile("" : "+v"(tid_));
    const int tid = tid_, wid = __builtin_amdgcn_readfirstlane(tid >> 6), lane = tid & 63, wr = wid >> 2, wc = wid & 3, fr = lane & 15, fq = lane >> 4;
    const int K = g.K, nt = K / BK;
    unsigned voffA[2], voffB[2];
#pragma unroll
    for (int i = 0; i < 2; ++i) { int R, C; stage_rc(tid * 16 + i * 8192, R, C); const int Rb = Epi::PERM ? ((R & ~31) + perm32(R & 31)) : R;
        voffA[i] = (unsigned)(R * K + C) * 2u; voffB[i] = (unsigned)(Rb * K + C) * 2u; }
    const size_t kstep = (size_t)(BK * 2);
    const size_t hstep = (size_t)HALF * K * 2;
    const size_t tstep = 2 * hstep;
    const unsigned ldsw = (unsigned)wid * 1024u;
    const int aoff = lds_byte(wr * 64 + fr, fq * 8), boff = lds_byte(wc * 32 + fr, fq * 8);
#define PG8_SA(b, h) (((b) * 2 + (h)) * HTB)
#define PG8_SB(b, h) ((4 + (b) * 2 + (h)) * HTB)
#define PG8_STAGE(bufoff, gbase, voff) do { _Pragma("unroll") for (int _i = 0; _i < 2; ++_i) \
        __builtin_amdgcn_global_load_lds((const unsigned*)((const char*)(gbase) + (voff)[_i]), (PG8_LAS unsigned*)(lds + (bufoff) + ldsw + _i * 8192), 16, 0, 0); } while (0)
#define PG8_LDA(dst, b, h) do { _Pragma("unroll") for (int m = 0; m < 4; ++m) _Pragma("unroll") for (int k = 0; k < 2; ++k) dst[m][k] = *(const PG8_LAS bf16x8*)(lds + PG8_SA(b, h) + aoff + m * 2048 + k * 1024); } while (0)
#define PG8_LDB(dst, b, h) do { _Pragma("unroll") for (int n = 0; n < 2; ++n) _Pragma("unroll") for (int k = 0; k < 2; ++k) dst[n][k] = *(const PG8_LAS bf16x8*)(lds + PG8_SB(b, h) + boff + n * 2048 + k * 1024); } while (0)
#define PG8_MMA(ai, bj, At, Bt) do { __builtin_amdgcn_s_setprio(1); _Pragma("unroll") for (int m = 0; m < 4; ++m) _Pragma("unroll") for (int n = 0; n < 2; ++n) _Pragma("unroll") for (int k = 0; k < 2; ++k) \
        acc[ai][bj][m][n] = __builtin_amdgcn_mfma_f32_16x16x32_bf16(Bt[n][k], At[m][k], acc[ai][bj][m][n], 0, 0, 0); __builtin_amdgcn_s_setprio(0); } while (0)
#define PG8_WAIT_V(n) asm volatile("s_waitcnt vmcnt(" #n ")" ::: "memory")
#define PG8_WAIT_L(n) asm volatile("s_waitcnt lgkmcnt(" #n ")" ::: "memory")
#define PG8_BAR __builtin_amdgcn_s_barrier()
#define PG8_SCHED __builtin_amdgcn_sched_barrier(0)
    Unit cur, nxt; int ui = 0;
    if (!S.next(0, cur)) return;
    f32x4 acc[2][2][4][2];
#pragma unroll
    for (int a = 0; a < 2; ++a)
#pragma unroll
        for (int b = 0; b < 2; ++b)
#pragma unroll
            for (int m = 0; m < 4; ++m)
#pragma unroll
                for (int n = 0; n < 2; ++n) acc[a][b][m][n] = (f32x4){0.f, 0.f, 0.f, 0.f};
    bf16x8 At[4][2], B0[2][2], B1[2][2];
    const char* cA = (const char*)g.A + (size_t)cur.pm * tstep; const char* cB = (const char*)g.Bt + (size_t)cur.pn * tstep;
    S.a_ready(cur);
    if constexpr (SP2) {
        PG8_STAGE(PG8_SB(0, 0), cB, voffB); PG8_STAGE(PG8_SB(0, 1), cB + hstep, voffB); PG8_STAGE(PG8_SA(0, 0), cA, voffA); PG8_STAGE(PG8_SA(0, 1), cA + hstep, voffA);
        if (wr == 1) PG8_BAR;
        PG8_WAIT_V(2); PG8_BAR;
        PG8_STAGE(PG8_SB(1, 0), cB + kstep, voffB); PG8_STAGE(PG8_SA(1, 0), cA + kstep, voffA); PG8_STAGE(PG8_SB(1, 1), cB + hstep + kstep, voffB);
        PG8_WAIT_V(6); PG8_BAR;
    } else {
        PG8_STAGE(PG8_SB(0, 0), cB, voffB); PG8_STAGE(PG8_SA(0, 0), cA, voffA); PG8_STAGE(PG8_SB(0, 1), cB + hstep, voffB); PG8_STAGE(PG8_SA(0, 1), cA + hstep, voffA);
        if (wr == 1) PG8_BAR;
        PG8_WAIT_V(4); PG8_BAR;
        PG8_STAGE(PG8_SB(1, 0), cB + kstep, voffB); PG8_STAGE(PG8_SA(1, 0), cA + kstep, voffA); PG8_STAGE(PG8_SB(1, 1), cB + hstep + kstep, voffB);
        PG8_WAIT_V(6); PG8_BAR;
    }
    for (;;) {
        const bool has_next = S.next(ui + 1, nxt);
        const char* nA = has_next ? (const char*)g.A + (size_t)nxt.pm * tstep : cA; const char* nB = has_next ? (const char*)g.Bt + (size_t)nxt.pn * tstep : cB;
        for (int t = 0; t < nt; t += 2) {
            const bool last = (t == nt - 2);
            const char* a1 = cA + (size_t)(t + 1) * kstep;
            const char* a2 = last ? nA : cA + (size_t)(t + 2) * kstep; const char* b2 = last ? nB : cB + (size_t)(t + 2) * kstep;
            const char* a3 = a2 + kstep; const char* b3 = b2 + kstep;
            if (last && has_next) S.a_ready(nxt);
            if constexpr (SP2) {
            PG8_LDB(B0, 0, 0); PG8_LDB(B1, 0, 1); PG8_SCHED; PG8_LDA(At, 0, 0); PG8_STAGE(PG8_SA(1, 1), a1 + hstep, voffA);
            PG8_WAIT_V(8); PG8_WAIT_L(0); PG8_BAR; PG8_MMA(0, 0, At, B0); PG8_MMA(0, 1, At, B1); PG8_BAR; PG8_SCHED;
            PG8_LDA(At, 0, 1); PG8_STAGE(PG8_SB(0, 0), b2, voffB); PG8_STAGE(PG8_SB(0, 1), b2 + hstep, voffB); PG8_STAGE(PG8_SA(0, 0), a2, voffA);
            PG8_WAIT_V(8); PG8_WAIT_L(0); PG8_BAR; PG8_MMA(1, 0, At, B0); PG8_MMA(1, 1, At, B1); PG8_BAR; PG8_SCHED;
            PG8_LDB(B0, 1, 0); PG8_LDB(B1, 1, 1); PG8_SCHED; PG8_LDA(At, 1, 0); PG8_STAGE(PG8_SA(0, 1), a2 + hstep, voffA);
            PG8_WAIT_V(8); PG8_WAIT_L(0); PG8_BAR; PG8_MMA(0, 0, At, B0); PG8_MMA(0, 1, At, B1); PG8_BAR; PG8_SCHED;
            PG8_LDA(At, 1, 1); PG8_STAGE(PG8_SB(1, 0), b3, voffB); PG8_STAGE(PG8_SB(1, 1), b3 + hstep, voffB); PG8_STAGE(PG8_SA(1, 0), a3, voffA);
            PG8_WAIT_V(8); PG8_WAIT_L(0); PG8_BAR; PG8_MMA(1, 0, At, B0); PG8_MMA(1, 1, At, B1); PG8_BAR; PG8_SCHED;
            } else {
            PG8_LDB(B0, 0, 0); PG8_SCHED; PG8_LDA(At, 0, 0); PG8_STAGE(PG8_SA(1, 1), a1 + hstep, voffA);
            PG8_WAIT_L(8); PG8_BAR; PG8_WAIT_L(0); PG8_MMA(0, 0, At, B0); PG8_BAR; PG8_SCHED;
            PG8_LDB(B1, 0, 1); PG8_STAGE(PG8_SB(0, 0), b2, voffB);
            PG8_BAR; PG8_WAIT_L(0); PG8_MMA(0, 1, At, B1); PG8_BAR;
            PG8_LDA(At, 0, 1); PG8_STAGE(PG8_SA(0, 0), a2, voffA);
            PG8_BAR; PG8_WAIT_L(0); PG8_MMA(1, 0, At, B0); PG8_BAR; PG8_SCHED;
            PG8_STAGE(PG8_SB(0, 1), b2 + hstep, voffB);
            PG8_WAIT_V(6); PG8_BAR; PG8_MMA(1, 1, At, B1); PG8_BAR;
            PG8_LDB(B0, 1, 0); PG8_SCHED; PG8_LDA(At, 1, 0); PG8_STAGE(PG8_SA(0, 1), a2 + hstep, voffA);
            PG8_WAIT_L(8); PG8_BAR; PG8_WAIT_L(0); PG8_MMA(0, 0, At, B0); PG8_BAR; PG8_SCHED;
            PG8_LDB(B1, 1, 1); PG8_STAGE(PG8_SB(1, 0), b3, voffB);
            PG8_BAR; PG8_WAIT_L(0); PG8_MMA(0, 1, At, B1); PG8_BAR;
            PG8_LDA(At, 1, 1); PG8_STAGE(PG8_SA(1, 0), a3, voffA);
            PG8_BAR; PG8_WAIT_L(0); PG8_MMA(1, 0, At, B0); PG8_BAR; PG8_SCHED;
            PG8_STAGE(PG8_SB(1, 1), b3 + hstep, voffB);
            PG8_WAIT_V(6); PG8_BAR; PG8_MMA(1, 1, At, B1); PG8_BAR;
            }
        }
        if constexpr (ALIGN_EPI) { if (wr == 0) PG8_BAR; }
        if constexpr (!Epi::AFTER_DRAIN) { E(acc, cur, wr, wc, fr, fq); S.done(cur); }
        if (!has_next) break;
#pragma unroll
        for (int a = 0; a < 2; ++a)
#pragma unroll
            for (int b = 0; b < 2; ++b)
#pragma unroll
                for (int m = 0; m < 4; ++m)
#pragma unroll
                    for (int n = 0; n < 2; ++n) acc[a][b][m][n] = (f32x4){0.f, 0.f, 0.f, 0.f};
        cur = nxt; cA = nA; cB = nB; ++ui;
        if constexpr (ALIGN_EPI) { if (wr == 1) PG8_BAR; }
    }
    PG8_WAIT_V(0);
    if constexpr (!ALIGN_EPI) { if (wr == 0) PG8_BAR; }
    PG8_BAR;
    if constexpr (Epi::AFTER_DRAIN) { E.fused(acc, cur, wr, wc, fr, fq, lds, wid, lane); S.done(cur); }
#undef PG8_SA
#undef PG8_SB
#undef PG8_STAGE
#undef PG8_LDA
#undef PG8_LDB
#undef PG8_MMA
#undef PG8_WAIT_V
#undef PG8_WAIT_L
#undef PG8_BAR
#undef PG8_SCHED
}
}

constexpr int NWAVES = 8;
constexpr int N_PHASES = 24;
constexpr size_t WS_CTL = 0, CTL_ZERO_BYTES = 1 * MiB;
constexpr size_t WS_ROPE = 1 * MiB;
constexpr size_t SZ_WIN = (size_t)2 * DFF * D * 2, SZ_WOUT = (size_t)D * DFF * 2;
constexpr size_t WS_WIN0 = 2 * MiB, WS_WOUT0 = WS_WIN0 + 2 * SZ_WIN, WS_WQKV = WS_WOUT0 + 2 * SZ_WOUT, WS_WOA = WS_WQKV + 3 * MiB;
constexpr size_t WS_WIN1 = 40 * MiB, WS_WOUT1 = WS_WIN1 + 2 * SZ_WIN, WS_WOR = WS_WOUT1 + 2 * SZ_WOUT, WS_W14 = WS_WOR + 2 * MiB, WS_W15 = WS_W14 + 14 * MiB;
constexpr size_t PS_YB = 2 * MiB;
constexpr size_t PS_XN = 92 * MiB;
constexpr size_t PS_F = PS_XN + 32 * MiB;
constexpr size_t PS_RKV = PS_XN;
constexpr size_t PS_HB = PS_F + 64 * MiB;
constexpr size_t PS_Q = PS_HB, PS_K = PS_HB + 32 * MiB, PS_V = PS_HB + 40 * MiB, PS_O = PS_HB + 48 * MiB;
constexpr size_t PS_XN2 = PS_HB, PS_LH = PS_HB + 64 * MiB, PS_DEC = PS_HB;
constexpr size_t PS_NC = PS_LH;
constexpr size_t PS_MC = 2 * MiB, PS_BON = 34 * MiB;
constexpr size_t PS_ICL = PS_NC + 32 * MiB, PS_GB = PS_ICL + 32 * MiB, PS_END = PS_GB + 32 * MiB;
static_assert(WS_WOA + 2 * MiB == 40 * MiB && WS_W15 + 3 * MiB == 92 * MiB && PS_NC == 252 * MiB && PS_END == 348 * MiB, "d_ws map");
constexpr int CW_BAR = 4096;
constexpr int RING_OFF = 0, RING_BYTES = 131072, LDSCTL_OFF = RING_BYTES, MISC_OFF = LDSCTL_OFF + 320, LDS_BYTES = 147456;

#define GAS __attribute__((address_space(1)))
#define LAS __attribute__((address_space(3)))
typedef unsigned v4u __attribute__((ext_vector_type(4)));
typedef unsigned v2u __attribute__((ext_vector_type(2)));
typedef float f32x4 __attribute__((ext_vector_type(4)));
typedef GAS unsigned gu32;
#define RLX_AGENT __ATOMIC_RELAXED, __HIP_MEMORY_SCOPE_AGENT
#define LDS_WAIT() asm volatile("s_waitcnt lgkmcnt(0)" ::: "memory")
#define VM_WAIT() asm volatile("s_waitcnt vmcnt(0)" ::: "memory")
__device__ __forceinline__ unsigned pk2(float lo, float hi) { return (unsigned)f2bf(lo) | ((unsigned)f2bf(hi) << 16); }

#define XB_TMO      128
#define XB_XCNT(j)  (256  + 64 * (j))
#define XB_XSUB(j)  (1280 + 64 * (j))
#define XB_XGEN(j)  (2304 + 64 * (j))
#define XB_TOP      3328
#define XB_TOPGEN   3392
#define XCD_BAR_WORDS 3456
#define XB_SPIN_CAP (1u << 18)

__device__ __forceinline__ unsigned xb_ld(unsigned* p)              { return __hip_atomic_load(p, __ATOMIC_RELAXED, __HIP_MEMORY_SCOPE_AGENT); }
__device__ __forceinline__ unsigned xb_add(unsigned* p, unsigned v) { return __hip_atomic_fetch_add(p, v, __ATOMIC_RELAXED, __HIP_MEMORY_SCOPE_AGENT); }
__device__ __forceinline__ unsigned xb_xcc_id() { return (unsigned)__builtin_amdgcn_s_getreg((3 << 11) | 20) & 0xFu; }
#define XB_SPIN(cond, bar) do { unsigned _sp = 0; while (cond) { __builtin_amdgcn_s_sleep(1); \
    if ((++_sp & 255u) == 0u) { if (xb_ld(&(bar)[XB_TMO])) break; if (_sp > XB_SPIN_CAP) { atomicAdd(&(bar)[XB_TMO], 1u); break; } } } } while (0)

struct XcdBarrier {
    unsigned* bar; unsigned x;
    volatile LAS unsigned* st;
};

__device__ __forceinline__ XcdBarrier xcd_barrier_post(unsigned* bar, volatile LAS unsigned* st) {
    XcdBarrier b; b.bar = bar; b.x = xb_xcc_id(); b.st = st;
    if (threadIdx.x == 0) (void)xb_add(&bar[XB_XCNT(b.x)], 1u);
    return b;
}
__device__ __forceinline__ void xcd_barrier_complete(unsigned* bar, unsigned x, unsigned& nloc, unsigned& nx) {
    const unsigned G = gridDim.x * gridDim.y * gridDim.z;
    unsigned sum, cnt, mine, sp = 0u;
    for (;;) {
        sum = 0u; cnt = 0u; mine = 0u;
#pragma unroll
        for (unsigned j = 0; j < 16; ++j) { const unsigned c = xb_ld(&bar[XB_XCNT(j)]); sum += c; cnt += (c > 0u) ? 1u : 0u; mine = (j == x) ? c : mine; }
        if (sum == G) break;
        __builtin_amdgcn_s_sleep(1);
        if ((++sp & 255u) == 0u) { if (xb_ld(&bar[XB_TMO])) break; if (sp > XB_SPIN_CAP) { atomicAdd(&bar[XB_TMO], 1u); break; } }
    }
    nloc = mine > 0u ? mine : 1u; nx = cnt > 0u ? cnt : 1u;
}

__device__ __forceinline__ void xcd_barrier(const XcdBarrier& b) {
    asm volatile("s_waitcnt vmcnt(0)" ::: "memory");
    __syncthreads();
    if (threadIdx.x == 0) {
        unsigned* bar = b.bar;
        __builtin_amdgcn_s_waitcnt(0);
        unsigned nloc = b.st[0], nx = b.st[1];
        if (nloc == 0u) { xcd_barrier_complete(bar, b.x, nloc, nx); b.st[0] = nloc; b.st[1] = nx; }
        const unsigned old = xb_add(&bar[XB_XSUB(b.x)], 1u);
        const unsigned gen = old / nloc;
        if (old + 1u == (gen + 1u) * nloc) {
            __builtin_amdgcn_fence(__ATOMIC_RELEASE, "agent");
            asm volatile("s_waitcnt vmcnt(0)" ::: "memory");
            const unsigned og = xb_add(&bar[XB_TOP], 1u);
            const unsigned tg = og / nx;
            if (og + 1u == (tg + 1u) * nx) xb_add(&bar[XB_TOPGEN], 1u);
            else XB_SPIN(xb_ld(&bar[XB_TOPGEN]) == tg, bar);
            __builtin_amdgcn_fence(__ATOMIC_ACQUIRE, "agent");
            xb_add(&bar[XB_XGEN(b.x)], 1u);
            asm volatile("s_waitcnt vmcnt(0)" ::: "memory");
        } else {
            XB_SPIN(xb_ld(&bar[XB_XGEN(b.x)]) == gen, bar);
            __builtin_amdgcn_fence(__ATOMIC_ACQUIRE, "agent");
            asm volatile("s_waitcnt vmcnt(0)" ::: "memory");
        }
    }
    __syncthreads();
}


struct Args { const float* in[24]; float* out; unsigned char* ws; int ph_lo, ph_hi, li, pad; };
struct Frame {
    LAS unsigned char* lds; volatile LAS unsigned* MISC; gu32* ctl;
    int tid, lane, wave, vcu, G, gw, NGW;
};

template <int MODE> __device__ __forceinline__ int dst_row(int n) {
    if (MODE == 1) { const int up = n >= DFF, nn = up ? n - DFF : n; return 256 * (nn >> 7) + 128 * up + (nn & 127); }
    if (MODE == 2) { const int head = n >> 6, d = n & 63, dd = d & 31; return head * 64 + 8 * (dd >> 2) + 4 * (d >> 5) + (dd & 3); }
    return n;
}
template <int MODE> __device__ __forceinline__ void p0_transpose_item(const float* W, int K, int N, bf16* WT, int ldd, int row_off, const float* mixv, LAS float* scr, int item, int lane) {
    const int nblk = N / 32, kb = item / nblk, nb = item % nblk, k0 = 64 * kb, n0 = 32 * nb;
#pragma unroll 8
    for (int i = 0; i < 32; ++i) { const int kk = 2 * i + (lane >> 5); scr[kk * 33 + (lane & 31)] = W[(size_t)(k0 + kk) * N + n0 + (lane & 31)]; }
    LDS_WAIT(); asm volatile("" ::: "memory");
    const int c = lane & 7;
    float mx[8];
#pragma unroll
    for (int i = 0; i < 8; ++i) mx[i] = (MODE == 3) ? mixv[k0 + 8 * c + i] : 0.f;
#pragma unroll
    for (int j = 0; j < 4; ++j) { const int n = (lane >> 3) + 8 * j; const LAS float* s = scr + (8 * c) * 33 + n;
        float v[8];
#pragma unroll
        for (int i = 0; i < 8; ++i) v[i] = s[i * 33];
        const int dr = (MODE == 3) ? (n0 + n) : dst_row<MODE>(n0 + n);
        bf16* drow = WT + (size_t)(row_off + dr) * ldd + k0 + 8 * c;
        if (MODE == 3) {
            v4u o; o.x = pk2(v[0] * (1.f - mx[0]), v[1] * (1.f - mx[1])); o.y = pk2(v[2] * (1.f - mx[2]), v[3] * (1.f - mx[3])); o.z = pk2(v[4] * (1.f - mx[4]), v[5] * (1.f - mx[5])); o.w = pk2(v[6] * (1.f - mx[6]), v[7] * (1.f - mx[7]));
            *(GAS v4u*)drow = o;
            v4u p; p.x = pk2(v[0] * mx[0], v[1] * mx[1]); p.y = pk2(v[2] * mx[2], v[3] * mx[3]); p.z = pk2(v[4] * mx[4], v[5] * mx[5]); p.w = pk2(v[6] * mx[6], v[7] * mx[7]);
            *(GAS v4u*)(drow + 1024) = p;
        } else { v4u o; o.x = pk2(v[0], v[1]); o.y = pk2(v[2], v[3]); o.z = pk2(v[4], v[5]); o.w = pk2(v[6], v[7]); *(GAS v4u*)drow = o; }
    }
    LDS_WAIT(); asm volatile("" ::: "memory");
}
__device__ __forceinline__ int fresh_tid() { int t = threadIdx.x; asm volatile("" : "+v"(t)); return t; }
__device__ __forceinline__ float wsum(float v) {
#pragma unroll
    for (int o = 1; o < 64; o <<= 1) v += __shfl_xor(v, o);
    return v;
}
__device__ __forceinline__ void p0_prologue(const Frame& F, const Args& a) {
    unsigned char* ws = a.ws; const int lane = fresh_tid() & 63;
    LAS float* scr = (LAS float*)(F.lds + RING_OFF + F.wave * 16384);
    const float* win = a.in[2]; const float* wout = a.in[3]; const float* mix = a.in[8]; const float* wrkv = a.in[9];
    constexpr int I_IN = (D / 64) * (2 * DFF / 32), I_OUT = (DFF / 64) * (D / 32), I_QKV = (D / 64) * (NQKV / 32), I_SQ = (D / 64) * (D / 32);
    constexpr int NITEMS = 4 * I_IN + 4 * I_OUT + I_QKV + 2 * I_SQ + 3 * I_SQ;
    for (int it = F.gw; it < NITEMS; it += F.NGW) {
        int r = it;
        if (r < 4 * I_IN) { const int q = r / I_IN; r -= q * I_IN;
            p0_transpose_item<1>(win + (size_t)q * D * 2 * DFF, D, 2 * DFF, (bf16*)(ws + (q < 2 ? WS_WIN0 : WS_WIN1) + (size_t)(q & 1) * SZ_WIN), D, 0, nullptr, scr, r, lane); continue; }
        r -= 4 * I_IN;
        if (r < 4 * I_OUT) { const int q = r / I_OUT; r -= q * I_OUT;
            p0_transpose_item<0>(wout + (size_t)q * DFF * D, DFF, D, (bf16*)(ws + (q < 2 ? WS_WOUT0 : WS_WOUT1) + (size_t)(q & 1) * SZ_WOUT), DFF, 0, nullptr, scr, r, lane); continue; }
        r -= 4 * I_OUT;
        if (r < I_QKV) { p0_transpose_item<2>(a.in[4], D, NQKV, (bf16*)(ws + WS_WQKV), D, 0, nullptr, scr, r, lane); continue; }
        r -= I_QKV;
        if (r < I_SQ) { p0_transpose_item<0>(a.in[7], D, D, (bf16*)(ws + WS_WOA), D, 0, nullptr, scr, r, lane); continue; }
        r -= I_SQ;
        if (r < I_SQ) { p0_transpose_item<0>(a.in[10], D, D, (bf16*)(ws + WS_WOR), D, 0, nullptr, scr, r, lane); continue; }
        r -= I_SQ;
        { const int z = r / I_SQ; r -= z * I_SQ; const int mi = (z == 0) ? 0 : (z == 1 ? 2 : 3);
          p0_transpose_item<3>(wrkv + (size_t)z * D * D, D, D, (bf16*)(ws + WS_W14), 2048, z * 1024, mix + mi * D, scr, r, lane); }
    }
    const int gt = F.gw * 64 + lane, NGT = F.NGW * 64;
    for (int e = gt; e < 512 * 2048 / 8; e += NGT) { const int n = e / 256, c8 = (e % 256) * 8;
        const float* W; int nn, ldw, mi; bool z = false;
        if (n < 64) { W = a.in[12]; nn = n; ldw = 64; mi = 1; } else if (n < 128) { W = a.in[15]; nn = n - 64; ldw = 64; mi = 4; } else if (n < 288) { W = a.in[17]; nn = n - 128; ldw = 160; mi = 5; } else { W = a.in[12]; nn = 0; ldw = 64; mi = 1; z = true; }
        float v[8];
#pragma unroll
        for (int i = 0; i < 8; ++i) { const int kf = c8 + i, k = kf & 1023; const float mv = mix[mi * D + k]; const float w = W[(size_t)k * ldw + nn]; v[i] = z ? 0.f : (kf < 1024 ? (1.f - mv) * w : mv * w); }
        v4u o; o.x = pk2(v[0], v[1]); o.y = pk2(v[2], v[3]); o.z = pk2(v[4], v[5]); o.w = pk2(v[6], v[7]);
        *(GAS v4u*)((bf16*)(ws + WS_W14) + (size_t)(3072 + n) * 2048 + c8) = o; }
    for (int e = gt; e < 3072 * 512 / 8; e += NGT) { const int n = e / 64, c8 = (e % 64) * 8, kind = n >> 10, nn = n & 1023;
        const float* W = kind == 0 ? a.in[13] : (kind == 1 ? a.in[16] : a.in[18]); const int lo = kind == 0 ? 0 : (kind == 1 ? 64 : 128), hi = kind == 0 ? 64 : (kind == 1 ? 128 : 288);
        float v[8];
#pragma unroll
        for (int i = 0; i < 8; ++i) { const int k = c8 + i; const bool in = (k >= lo && k < hi); v[i] = in ? W[(size_t)(in ? k - lo : 0) * D + nn] : 0.f; }
        v4u o; o.x = pk2(v[0], v[1]); o.y = pk2(v[2], v[3]); o.z = pk2(v[4], v[5]); o.w = pk2(v[6], v[7]);
        *(GAS v4u*)((bf16*)(ws + WS_W15) + (size_t)n * 512 + c8) = o; }
    for (int e = gt; e < SEQ * 32; e += NGT) { const int pos = e >> 5, d = e & 31; const float inv = powf(10000.f, -(float)(2 * d) / 64.f), ang = (float)pos * inv;
        ((float*)(ws + WS_ROPE))[e] = cosf(ang); ((float*)(ws + WS_ROPE))[SEQ * 32 + e] = sinf(ang); }
}

__device__ __forceinline__ void np_phase(const Frame& F, const float* base, const float* Fm, const float* gpost, const float* gpre, float* xo, bf16* XN, float scale, int mode) {
    const int lane = fresh_tid() & 63;
    for (int m = F.gw; m < M; m += F.NGW) {
        const GAS f32x4* br = (const GAS f32x4*)(base + (size_t)m * D) + lane;
        f32x4 v[4]; float s2 = 0.f;
        if (mode != 3) {
            const GAS f32x4* fr = (const GAS f32x4*)(Fm + (size_t)m * D) + lane;
            f32x4 f[4]; float ss = 0.f;
#pragma unroll
            for (int j = 0; j < 4; ++j) { f[j] = fr[64 * j]; v[j] = br[64 * j]; ss += (f[j].x * f[j].x + f[j].y * f[j].y) + (f[j].z * f[j].z + f[j].w * f[j].w); }
            const float r1 = rsqrtf(wsum(ss) * (1.f / D) + RMS_EPS) * scale;
            GAS f32x4* orow = (GAS f32x4*)(xo + (size_t)m * D) + lane;
#pragma unroll
            for (int j = 0; j < 4; ++j) { const f32x4 gp = ((const GAS f32x4*)gpost)[64 * j + lane]; v[j] = v[j] + (f[j] * r1) * gp; orow[64 * j] = v[j]; }
        } else {
#pragma unroll
            for (int j = 0; j < 4; ++j) v[j] = br[64 * j];
        }
        if (mode == 0) continue;
#pragma unroll
        for (int j = 0; j < 4; ++j) s2 += (v[j].x * v[j].x + v[j].y * v[j].y) + (v[j].z * v[j].z + v[j].w * v[j].w);
        const float r2 = rsqrtf(wsum(s2) * (1.f / D) + RMS_EPS);
#pragma unroll
        for (int j = 0; j < 4; ++j) { const f32x4 gq = ((const GAS f32x4*)gpre)[64 * j + lane]; const f32x4 o = (v[j] * r2) * gq;
            v2u w; w.x = pk2(o.x, o.y); w.y = pk2(o.z, o.w); const int c = 256 * j + 4 * lane;
            if (mode != 2) *(GAS v2u*)(XN + (size_t)m * D + c) = w;
            else { *(GAS v2u*)(XN + (size_t)m * 2048 + c) = w; if ((m & (SEQ - 1)) != SEQ - 1) *(GAS v2u*)(XN + (size_t)(m + 1) * 2048 + 1024 + c) = w;
                   if ((m & (SEQ - 1)) == 0) *(GAS v2u*)(XN + (size_t)m * 2048 + 1024 + c) = (v2u){0u, 0u}; } }
    }
}

typedef short bf16x8 __attribute__((ext_vector_type(8)));
typedef short s16x4 __attribute__((ext_vector_type(4)));
typedef float f32x16 __attribute__((ext_vector_type(16)));
constexpr int AT_KS = 144, AT_VS = 520;
constexpr int AT_VOFF = 256 * AT_KS;
__device__ __forceinline__ int crow(int reg, int h) { return (reg & 3) + 8 * (reg >> 2) + 4 * h; }
__device__ __forceinline__ void attn_phase(const Frame& F, const bf16* Q, const bf16* Kb, const bf16* Vb, const float* sinks, bf16* O) {
    const int tid = fresh_tid(), lane = tid & 63, r = lane & 31, h = lane >> 5, wave = F.wave;
    LAS unsigned char* Ks = F.lds + RING_OFF; LAS unsigned char* Vt = Ks + AT_VOFF;
    constexpr float C2 = 0.125f * 1.4426950408889634f, L2E = 1.4426950408889634f;
    for (int u = F.vcu; u < BATCH * NKV * (SEQ / WIN); u += F.G) {
        const int b = u >> 7, hk = (u >> 5) & 3, n = u & 31;
        const int row0 = b * SEQ + n * WIN;
        __syncthreads();
#pragma unroll
        for (int i = 0; i < 4; ++i) { const int idx = tid + i * 512, key = idx >> 3, ch = idx & 7; const size_t tok = (size_t)(row0 - WIN + key);
            v4u kv = (v4u){0u, 0u, 0u, 0u}, vv = (v4u){0u, 0u, 0u, 0u};
            if (n > 0 || key >= WIN) { kv = *(const GAS v4u*)(Kb + tok * 256 + hk * 64 + ch * 8); vv = *(const GAS v4u*)(Vb + tok * 256 + hk * 64 + ch * 8); }
            *(LAS v4u*)(Ks + key * AT_KS + ch * 16) = kv;
            LAS unsigned short* vt = (LAS unsigned short*)(Vt + (ch * 8) * AT_VS + key * 2);
            vt[0 * (AT_VS / 2)] = (unsigned short)(vv.x & 0xffffu); vt[1 * (AT_VS / 2)] = (unsigned short)(vv.x >> 16);
            vt[2 * (AT_VS / 2)] = (unsigned short)(vv.y & 0xffffu); vt[3 * (AT_VS / 2)] = (unsigned short)(vv.y >> 16);
            vt[4 * (AT_VS / 2)] = (unsigned short)(vv.z & 0xffffu); vt[5 * (AT_VS / 2)] = (unsigned short)(vv.z >> 16);
            vt[6 * (AT_VS / 2)] = (unsigned short)(vv.w & 0xffffu); vt[7 * (AT_VS / 2)] = (unsigned short)(vv.w >> 16); }
        __syncthreads();
#pragma unroll 1
        for (int pi = 0; pi < 2; ++pi) {
            const int p = wave * 2 + pi, g = p >> 2, qt = p & 3, q0 = 32 * qt, head = hk * 4 + g, qi = q0 + r;
            const bf16* qp = Q + (size_t)(row0 + qi) * D + head * 64 + 8 * h;
            bf16x8 qf[4];
#pragma unroll
            for (int ks = 0; ks < 4; ++ks) qf[ks] = *(const GAS bf16x8*)(qp + 16 * ks);
            f32x16 s[5];
#pragma unroll
            for (int t = 0; t < 5; ++t) { const LAS unsigned char* kp = Ks + (32 * (qt + t) + r) * AT_KS + 16 * h;
#pragma unroll
                for (int e = 0; e < 16; ++e) s[t][e] = 0.f;
#pragma unroll
                for (int ks = 0; ks < 4; ++ks) { const bf16x8 kf = *(const LAS bf16x8*)(kp + 32 * ks); s[t] = __builtin_amdgcn_mfma_f32_32x32x16_bf16(kf, qf[ks], s[t], 0, 0, 0); } }
            float mx = -INFINITY;
#pragma unroll
            for (int t = 0; t < 5; ++t)
#pragma unroll
                for (int e = 0; e < 16; ++e) { const int j = 32 * (qt + t) + crow(e, h); const bool ok = (j > qi) && (j <= qi + WIN) && (n > 0 || j >= WIN);
                    const float v = ok ? s[t][e] * C2 : -INFINITY; s[t][e] = v; mx = fmaxf(mx, v); }
            mx = fmaxf(mx, __shfl_xor(mx, 32));
            const float sink2 = sinks[head] * L2E; mx = fmaxf(mx, sink2);
            float l = 0.f;
#pragma unroll
            for (int t = 0; t < 5; ++t)
#pragma unroll
                for (int e = 0; e < 16; ++e) { const float pv = __builtin_amdgcn_exp2f(s[t][e] - mx); s[t][e] = pv; l += pv; }
            l += __shfl_xor(l, 32); l += __builtin_amdgcn_exp2f(sink2 - mx);
            const float inv = 1.f / l;
            f32x16 o[2];
#pragma unroll
            for (int e = 0; e < 16; ++e) { o[0][e] = 0.f; o[1][e] = 0.f; }
#pragma unroll
            for (int t = 0; t < 5; ++t)
#pragma unroll
                for (int ss = 0; ss < 2; ++ss) {
                    v4u pw; pw.x = pk2(s[t][8 * ss + 0] * inv, s[t][8 * ss + 1] * inv); pw.y = pk2(s[t][8 * ss + 2] * inv, s[t][8 * ss + 3] * inv);
                    pw.z = pk2(s[t][8 * ss + 4] * inv, s[t][8 * ss + 5] * inv); pw.w = pk2(s[t][8 * ss + 6] * inv, s[t][8 * ss + 7] * inv);
                    const bf16x8 pa = __builtin_bit_cast(bf16x8, pw);
#pragma unroll
                    for (int dt = 0; dt < 2; ++dt) { const LAS unsigned char* vp = Vt + (32 * dt + r) * AT_VS + (32 * (qt + t) + 16 * ss + 4 * h) * 2;
                        const s16x4 lo = *(const LAS s16x4*)vp, hi = *(const LAS s16x4*)(vp + 16);
                        const bf16x8 vb = __builtin_shufflevector(lo, hi, 0, 1, 2, 3, 4, 5, 6, 7);
                        o[dt] = __builtin_amdgcn_mfma_f32_32x32x16_bf16(pa, vb, o[dt], 0, 0, 0); } }
            bf16* op = O + (size_t)(row0 + q0) * D + head * 64 + r;
#pragma unroll
            for (int dt = 0; dt < 2; ++dt)
#pragma unroll
                for (int e = 0; e < 16; ++e) op[(size_t)crow(e, h) * D + 32 * dt] = f2bf(o[dt][e]);
        }
    }
    __syncthreads();
}

constexpr int SC = 128, NCH = SEQ / SC, NTASK = BATCH * NH * NCH;
__device__ __forceinline__ void scan_pass1(const Frame& F, bf16* R, const bf16* Kx, const bf16* V, float* DEC, const bf16* ICL, const float* k_k, const float* k_a, const float* r_k, float* Mc, float* Nc, float* BON) {
    const int lane = fresh_tid() & 63;
    LAS float* sv = (LAS float*)(F.lds + RING_OFF) + F.wave * 320;
    for (int task = F.gw; task < NTASK; task += F.NGW) {
        const int h = task & 15, c = (task >> 4) & (NCH - 1), b = task >> 9, ch = h * 64 + lane;
        const size_t row0 = (size_t)b * SEQ + (size_t)c * SC;
        const float kkc = k_k[ch], kac = k_a[ch], rkc = r_k[ch];
        float I[64], S[64];
        int ln = lane; asm volatile("" : "+v"(ln));
#pragma unroll
        for (int j = 0; j < 64; ++j) { I[j] = (j == ln) ? 1.f : 0.f; S[j] = 0.f; }
        size_t o = row0 * D + ch;
        float r_n = bf2f(R[o]), k_n = bf2f(Kx[o]), v_n = bf2f(V[o]), w_n = DEC[o], ic_n = bf2f(ICL[o]);
#pragma unroll 1
        for (int t = 0; t < SC; ++t) {
            const float r = r_n, k = k_n, v = v_n, w = w_n, ic = ic_n; const size_t oc = o;
            if (t + 1 < SC) { o += D; r_n = bf2f(R[o]); k_n = bf2f(Kx[o]); v_n = bf2f(V[o]); w_n = DEC[o]; ic_n = bf2f(ICL[o]); }
            float kk = k * kkc; const float nrm = sqrtf(wsum(kk * kk)); kk = kk / fmaxf(nrm, 1e-12f);
            const float k2 = k * (1.f + (ic - 1.f) * kac);
            const float bon = wsum(r * k2 * rkc);
            sv[lane] = -kk; sv[64 + lane] = w; sv[128 + lane] = kk * ic; sv[192 + lane] = k2; sv[256 + lane] = r;
            float si0 = 0.f, si1 = 0.f, si2 = 0.f, si3 = 0.f, ss0 = 0.f, ss1 = 0.f, ss2 = 0.f, ss3 = 0.f;
#pragma unroll
            for (int j = 0; j < 64; j += 4) { const f32x4 a4 = *(const LAS f32x4*)(sv + j);
                si0 += I[j] * a4.x; si1 += I[j + 1] * a4.y; si2 += I[j + 2] * a4.z; si3 += I[j + 3] * a4.w;
                ss0 += S[j] * a4.x; ss1 += S[j + 1] * a4.y; ss2 += S[j + 2] * a4.z; ss3 += S[j + 3] * a4.w;
                if ((j & 12) == 12) asm volatile("" ::: "memory"); }
            const float saI = (si0 + si1) + (si2 + si3), saV = (ss0 + ss1) + (ss2 + ss3);
            float g0 = 0.f, g1 = 0.f, g2 = 0.f, g3 = 0.f, y0 = 0.f, y1 = 0.f, y2 = 0.f, y3 = 0.f;
#pragma unroll
            for (int j = 0; j < 64; j += 4) { const f32x4 w4 = *(const LAS f32x4*)(sv + 64 + j), b4 = *(const LAS f32x4*)(sv + 128 + j), k4 = *(const LAS f32x4*)(sv + 192 + j), r4 = *(const LAS f32x4*)(sv + 256 + j);
                I[j] = I[j] * w4.x + saI * b4.x; I[j + 1] = I[j + 1] * w4.y + saI * b4.y; I[j + 2] = I[j + 2] * w4.z + saI * b4.z; I[j + 3] = I[j + 3] * w4.w + saI * b4.w;
                g0 += I[j] * r4.x; g1 += I[j + 1] * r4.y; g2 += I[j + 2] * r4.z; g3 += I[j + 3] * r4.w;
                S[j] = S[j] * w4.x + (saV * b4.x + v * k4.x); S[j + 1] = S[j + 1] * w4.y + (saV * b4.y + v * k4.y); S[j + 2] = S[j + 2] * w4.z + (saV * b4.z + v * k4.z); S[j + 3] = S[j + 3] * w4.w + (saV * b4.w + v * k4.w);
                y0 += S[j] * r4.x; y1 += S[j + 1] * r4.y; y2 += S[j + 2] * r4.z; y3 += S[j + 3] * r4.w;
                if (j & 4) asm volatile("" ::: "memory"); }
            R[oc] = f2bf((g0 + g1) + (g2 + g3)); DEC[oc] = (y0 + y1) + (y2 + y3);
            if (lane == 0) BON[(row0 + t) * 16 + h] = bon;
        }
        GAS f32x4* mo = (GAS f32x4*)(Mc + (size_t)task * 4096 + lane * 64); GAS f32x4* no = (GAS f32x4*)(Nc + (size_t)task * 4096 + lane * 64);
#pragma unroll
        for (int j = 0; j < 64; j += 4) { mo[j >> 2] = (f32x4){I[j], I[j + 1], I[j + 2], I[j + 3]}; no[j >> 2] = (f32x4){S[j], S[j + 1], S[j + 2], S[j + 3]}; }
    }
}
__device__ __forceinline__ void scan_passB(const Frame& F, const float* Mc, float* Nc) {
    const int lane = fresh_tid() & 63;
    LAS float* Sl = (LAS float*)(F.lds + RING_OFF) + F.wave * 512;
    for (int task = F.wave * F.G + F.vcu; task < BATCH * NH * 8; task += F.NGW) {
        const int hb = task >> 3, rg = task & 7, b = hb >> 4, h = hb & 15;
#pragma unroll
        for (int i = 0; i < 8; ++i) Sl[i * 64 + lane] = 0.f;
        float mcn[64];
        { const float* mp = Mc + (size_t)((b * NCH + 0) * 16 + h) * 4096 + lane;
#pragma unroll
          for (int j = 0; j < 64; ++j) mcn[j] = mp[j * 64]; }
#pragma unroll 1
        for (int c = 0; c < NCH; ++c) {
            const size_t tk = (size_t)((b * NCH + c) * 16 + h);
            float mc[64];
#pragma unroll
            for (int j = 0; j < 64; ++j) mc[j] = mcn[j];
            if (c + 1 < NCH) { const float* mp = Mc + (tk + 16) * 4096 + lane;
#pragma unroll
                for (int j = 0; j < 64; ++j) mcn[j] = mp[j * 64]; }
            float* np = Nc + tk * 4096 + (size_t)(8 * rg) * 64 + lane;
            float acc[8];
#pragma unroll
            for (int i = 0; i < 8; ++i) acc[i] = np[i * 64];
#pragma unroll
            for (int j = 0; j < 64; j += 4)
#pragma unroll
                for (int i = 0; i < 8; ++i) { const f32x4 s4 = *(const LAS f32x4*)(Sl + i * 64 + j); acc[i] += (s4.x * mc[j] + s4.y * mc[j + 1]) + (s4.z * mc[j + 2] + s4.w * mc[j + 3]); }
#pragma unroll
            for (int i = 0; i < 8; ++i) { Sl[i * 64 + lane] = acc[i]; np[i * 64] = acc[i]; }
        }
    }
}
__device__ __forceinline__ void scan_passC(const Frame& F, const bf16* G, const float* Y0, const bf16* V, const bf16* GB, const float* BON, const float* Sst, const float* lnx_g, const float* lnx_b, bf16* YB) {
    const int lane = fresh_tid() & 63;
    LAS float* gl = (LAS float*)(F.lds + RING_OFF) + F.wave * 64;
    for (int task = F.gw; task < NTASK; task += F.NGW) {
        const int h = task & 15, c = (task >> 4) & (NCH - 1), b = task >> 9, ch = h * 64 + lane;
        const size_t row0 = (size_t)b * SEQ + (size_t)c * SC;
        const float lg = lnx_g[ch], lb = lnx_b[ch];
        float S[64];
        if (c > 0) { const GAS f32x4* sp = (const GAS f32x4*)(Sst + (size_t)(task - 16) * 4096 + lane * 64);
#pragma unroll
            for (int j = 0; j < 64; j += 4) { const f32x4 v4 = sp[j >> 2]; S[j] = v4.x; S[j + 1] = v4.y; S[j + 2] = v4.z; S[j + 3] = v4.w; } }
        else {
#pragma unroll
            for (int j = 0; j < 64; ++j) S[j] = 0.f; }
#pragma unroll 1
        for (int t = 0; t < SC; ++t) {
            const size_t o = (row0 + t) * D + ch;
            gl[lane] = bf2f(G[o]);
            float y0 = Y0[o], y1 = 0.f, y2 = 0.f, y3 = 0.f;
            const float v = bf2f(V[o]), gt = bf2f(GB[o]), bon = BON[(row0 + t) * 16 + h];
#pragma unroll
            for (int j = 0; j < 64; j += 4) { const f32x4 g4 = *(const LAS f32x4*)(gl + j); y0 += S[j] * g4.x; y1 += S[j + 1] * g4.y; y2 += S[j + 2] * g4.z; y3 += S[j + 3] * g4.w; }
            const float y = (y0 + y1) + (y2 + y3);
            const float mu = wsum(y) * (1.f / 64.f), dy = y - mu, var = wsum(dy * dy) * (1.f / 64.f);
            const float yn = dy * rsqrtf(var + LNX_EPS) * lg + lb;
            YB[o] = f2bf((yn + bon * v) * gt);
        }
    }
}

#ifndef SP2
#define SP2 true
#endif
__global__ void __launch_bounds__(NWAVES * 64, 2) mega(Args args) {
    extern __shared__ __attribute__((aligned(16))) unsigned char lds[];
    Frame F;
    F.lds = (LAS unsigned char*)lds; F.MISC = (volatile LAS unsigned*)(F.lds + MISC_OFF);
    F.tid = threadIdx.x; F.lane = F.tid & 63; F.wave = __builtin_amdgcn_readfirstlane(F.tid >> 6);
    F.G = gridDim.x; { const int bx = blockIdx.x; F.vcu = (F.G % 8 == 0) ? (bx % 8) * (F.G / 8) + bx / 8 : bx; }
    F.gw = F.vcu * NWAVES + F.wave; F.NGW = F.G * NWAVES;
    unsigned char* ws = args.ws; F.ctl = (gu32*)(ws + WS_CTL);
    for (int u = F.tid; u < (LDS_BYTES - LDSCTL_OFF) / 4; u += NWAVES * 64) ((LAS unsigned*)(F.lds + LDSCTL_OFF))[u] = 0u;
    __syncthreads();
    const int lo = args.ph_lo, hi = args.ph_hi;
    XcdBarrier bar; bar.bar = (unsigned*)(F.ctl + CW_BAR) + args.li * XCD_BAR_WORDS; bar.x = 0; bar.st = nullptr;
    if (hi - lo > 1) bar = xcd_barrier_post((unsigned*)(F.ctl + CW_BAR) + args.li * XCD_BAR_WORDS, F.MISC + 8);
#ifndef PHASE_MASK
#define PHASE_MASK 0xffffffull
#endif
#define IN(k) (((PHASE_MASK >> (k)) & 1ull) && lo <= (k) && (k) < hi)
#define SEAM(k) do { if (IN(k) && IN((k) + 1)) xcd_barrier(bar); } while (0)
    const float* x_in = args.in[0]; const float* ng = args.in[1]; float* out = args.out;
    bf16* XN = (bf16*)(ws + PS_XN); float* Fb = (float*)(ws + PS_F); bf16* HB = (bf16*)(ws + PS_HB);
    bf16* Qb = (bf16*)(ws + PS_Q); bf16* Kb = (bf16*)(ws + PS_K); bf16* Vb = (bf16*)(ws + PS_V); bf16* OB = (bf16*)(ws + PS_O);
    bf16* XN2 = (bf16*)(ws + PS_XN2); bf16* LH = (bf16*)(ws + PS_LH); float* DEC = (float*)(ws + PS_DEC);
    bf16* RKV = (bf16*)(ws + PS_RKV); bf16* ICL = (bf16*)(ws + PS_ICL); bf16* GB = (bf16*)(ws + PS_GB); bf16* YB = (bf16*)(ws + PS_YB);
    const float* cosT = (const float*)(ws + WS_ROPE); const float* sinT = cosT + SEQ * 32;
#define NG(l, i) (ng + (size_t)((l) * 6 + (i)) * D)
#define GEMM(EPI, E, Aptr, Bptr, NN, KK) do { pg8::Gemm g{(const pg8::bf16_t*)(Aptr), (const pg8::bf16_t*)(Bptr), M, (NN), (KK)}; pg8::StaticOrder S; S.init(M, (NN), F.G, (int)blockIdx.x); \
        pg8::gemm_phase<EPI, pg8::StaticOrder, true, SP2>(F.lds + RING_OFF, g, S, E); } while (0)
    if (IN(0)) { p0_prologue(F, args); np_phase(F, x_in, nullptr, nullptr, NG(0, 0), nullptr, XN, 1.f, 3); } SEAM(0);
    if (IN(1)) { pg8::EpiSwiglu E{HB}; GEMM(pg8::EpiSwiglu, E, XN, ws + WS_WIN0, 2 * DFF, D); } SEAM(1);
    if (IN(2)) { pg8::EpiF32 E{Fb, D}; GEMM(pg8::EpiF32, E, HB, ws + WS_WOUT0, D, DFF); } SEAM(2);
    if (IN(3)) np_phase(F, x_in, Fb, NG(0, 1), NG(0, 2), out, XN, 0.5f, 1); SEAM(3);
    if (IN(4)) { pg8::EpiQKV E{Qb, Kb, Vb, args.in[5], cosT, sinT}; GEMM(pg8::EpiQKV, E, XN, ws + WS_WQKV, NQKV, D); } SEAM(4);
    if (IN(5)) attn_phase(F, Qb, Kb, Vb, args.in[6], OB); SEAM(5);
    if (IN(6)) { pg8::EpiF32 E{Fb, D}; GEMM(pg8::EpiF32, E, OB, ws + WS_WOA, D, D); } SEAM(6);
    if (IN(7)) np_phase(F, out, Fb, NG(0, 3), NG(0, 4), out, XN, 1.0f, 1); SEAM(7);
    if (IN(8)) { pg8::EpiSwiglu E{HB}; GEMM(pg8::EpiSwiglu, E, XN, ws + WS_WIN0 + SZ_WIN, 2 * DFF, D); } SEAM(8);
    if (IN(9)) { pg8::EpiF32 E{Fb, D}; GEMM(pg8::EpiF32, E, HB, ws + WS_WOUT0 + SZ_WOUT, D, DFF); } SEAM(9);
    if (IN(10)) np_phase(F, out, Fb, NG(0, 5), NG(1, 0), out, XN, 0.5f, 1); SEAM(10);
    if (IN(11)) { pg8::EpiSwiglu E{HB}; GEMM(pg8::EpiSwiglu, E, XN, ws + WS_WIN1, 2 * DFF, D); } SEAM(11);
    if (IN(12)) { pg8::EpiF32 E{Fb, D}; GEMM(pg8::EpiF32, E, HB, ws + WS_WOUT1, D, DFF); } SEAM(12);
    if (IN(13)) np_phase(F, out, Fb, NG(1, 1), NG(1, 2), out, XN2, 0.5f, 2); SEAM(13);
    if (IN(14)) { pg8::EpiRwkv1 E{RKV, LH}; GEMM(pg8::EpiRwkv1, E, XN2, ws + WS_W14, 3584, 2048); } SEAM(14);
    if (IN(15)) { pg8::EpiRwkv2 E{DEC, ICL, GB, args.in[11], args.in[14]}; GEMM(pg8::EpiRwkv2, E, LH, ws + WS_W15, 3072, 512); } SEAM(15);
    if (IN(16)) scan_pass1(F, RKV, RKV + (size_t)M * D, RKV + (size_t)2 * M * D, DEC, ICL, args.in[19], args.in[20], args.in[21], (float*)(ws + PS_MC), (float*)(ws + PS_NC), (float*)(ws + PS_BON)); SEAM(16);
    if (IN(17)) scan_passB(F, (const float*)(ws + PS_MC), (float*)(ws + PS_NC)); SEAM(17);
    if (IN(18)) scan_passC(F, RKV, DEC, RKV + (size_t)2 * M * D, GB, (const float*)(ws + PS_BON), (const float*)(ws + PS_NC), args.in[22], args.in[23], YB); SEAM(18);
    if (IN(19)) { pg8::EpiF32 E{Fb, D}; GEMM(pg8::EpiF32, E, YB, ws + WS_WOR, D, D); } SEAM(19);
    if (IN(20)) np_phase(F, out, Fb, NG(1, 3), NG(1, 4), out, XN, 1.0f, 1); SEAM(20);
    if (IN(21)) { pg8::EpiSwiglu E{HB}; GEMM(pg8::EpiSwiglu, E, XN, ws + WS_WIN1 + SZ_WIN, 2 * DFF, D); } SEAM(21);
    if (IN(22)) { pg8::EpiF32 E{Fb, D}; GEMM(pg8::EpiF32, E, HB, ws + WS_WOUT1 + SZ_WOUT, D, DFF); } SEAM(22);
    if (IN(23)) np_phase(F, out, Fb, NG(1, 5), nullptr, out, XN, 0.5f, 0);
#undef IN
#undef SEAM
}

#ifndef NAIVE_MASK
#define NAIVE_MASK 0ull
#endif
#ifndef ONE_LAUNCH
#define ONE_LAUNCH 1
#endif
extern "C" void kernel_launch(void* const* d_in, const int* in_sizes, int n_in, void* d_out, int out_size, void* d_ws, size_t ws_size, hipStream_t stream) {
    static int grid = 0;
    if (grid == 0) {
        if (n_in != 24 || out_size != M * D || ws_size < PS_END) { fprintf(stderr, "kernel_launch: unexpected shapes n_in %d out %d ws %zu (need %zu)\n", n_in, out_size, ws_size, (size_t)PS_END); grid = -1; return; }
        int dev = 0, cus = 0, per_cu = 0;
        if (hipGetDevice(&dev) != hipSuccess || hipDeviceGetAttribute(&cus, hipDeviceAttributeMultiprocessorCount, dev) != hipSuccess) { grid = -1; return; }
        if (hipFuncSetAttribute((const void*)mega, hipFuncAttributeMaxDynamicSharedMemorySize, LDS_BYTES) != hipSuccess) { fprintf(stderr, "kernel_launch: hipFuncSetAttribute failed\n"); grid = -1; return; }
        if (hipOccupancyMaxActiveBlocksPerMultiprocessor(&per_cu, (const void*)mega, NWAVES * 64, LDS_BYTES) != hipSuccess || per_cu < 1) fprintf(stderr, "kernel_launch: occupancy query says %d\n", per_cu);
        (void)hipGetLastError();
        grid = cus;
    }
    if (grid < 0) return;
    const float* x = (const float*)d_in[0]; const float* ng = (const float*)d_in[1]; const float* win = (const float*)d_in[2]; const float* wout = (const float*)d_in[3];
    const float* wqkv = (const float*)d_in[4]; const float* bqkv = (const float*)d_in[5]; const float* sinks = (const float*)d_in[6]; const float* wo_a = (const float*)d_in[7];
    const float* mix = (const float*)d_in[8]; const float* wrkv = (const float*)d_in[9]; const float* wo_r = (const float*)d_in[10]; const float* w0 = (const float*)d_in[11];
    const float* w1 = (const float*)d_in[12]; const float* w2 = (const float*)d_in[13]; const float* a0 = (const float*)d_in[14]; const float* a1 = (const float*)d_in[15];
    const float* a2 = (const float*)d_in[16]; const float* g1 = (const float*)d_in[17]; const float* g2 = (const float*)d_in[18]; const float* k_k = (const float*)d_in[19];
    const float* k_a = (const float*)d_in[20]; const float* r_k = (const float*)d_in[21]; const float* lnx_g = (const float*)d_in[22]; const float* lnx_b = (const float*)d_in[23];
    float* out = (float*)d_out; unsigned char* ws = (unsigned char*)d_ws;
    bf16* XN = (bf16*)(ws + PS_XN); float* F = (float*)(ws + PS_F); bf16* HB = (bf16*)(ws + PS_HB);
    bf16* Q = (bf16*)(ws + PS_Q); bf16* Kb = (bf16*)(ws + PS_K); bf16* Vb = (bf16*)(ws + PS_V); bf16* OB = (bf16*)(ws + PS_O);
    bf16* XN2 = (bf16*)(ws + PS_XN2); bf16* LH = (bf16*)(ws + PS_LH); float* DEC = (float*)(ws + PS_DEC);
    bf16* RKV = (bf16*)(ws + PS_RKV); bf16* ICL = (bf16*)(ws + PS_ICL); bf16* GB = (bf16*)(ws + PS_GB); bf16* YB = (bf16*)(ws + PS_YB);
    const dim3 blk(256);
    auto G = [&](int l, int i) { return ng + (size_t)(l * 6 + i) * D; };
    auto n_swiglu = [&](int l, int f) { OpSwiglu o{XN, win + (size_t)(l * 2 + f) * D * 2 * DFF, HB, D, 2 * DFF, DFF, 0}; hipLaunchKernelGGL(ngemm<OpSwiglu>, dim3(DFF / 64, M / 64), blk, 0, stream, o); };
    auto n_out = [&](int l, int f) { OpF32 o{HB, wout + (size_t)(l * 2 + f) * DFF * D, F, DFF, D, D, DFF}; hipLaunchKernelGGL(ngemm<OpF32>, dim3(D / 64, M / 64), blk, 0, stream, o); };
    auto n_np = [&](const float* base, const float* gpost, const float* gpre, bf16* xn, float scale, int mode) { hipLaunchKernelGGL(k_np, dim3(M / 4), blk, 0, stream, base, (const float*)F, gpost, gpre, out, xn, scale, mode); };
    auto naive_phase = [&](int p) {
        switch (p) {
        case 0: hipLaunchKernelGGL(k_prenorm, dim3(M / 4), blk, 0, stream, x, G(0, 0), XN); break;
        case 1: n_swiglu(0, 0); break;
        case 2: n_out(0, 0); break;
        case 3: n_np(x, G(0, 1), G(0, 2), XN, 0.5f, 1); break;
        case 4: { OpQKrope o{XN, wqkv, bqkv, Q, Kb, D, NQKV, 640, 0}; hipLaunchKernelGGL(ngemm<OpQKrope>, dim3(10, M / 64), blk, 0, stream, o);
                  OpV ov{XN, wqkv, bqkv, Vb, D, NQKV, 256, 0}; hipLaunchKernelGGL(ngemm<OpV>, dim3(4, M / 64), blk, 0, stream, ov); } break;
        case 5: hipLaunchKernelGGL(k_attn, dim3(M * NH / 4), blk, 0, stream, (const bf16*)Q, (const bf16*)Kb, (const bf16*)Vb, sinks, OB); break;
        case 6: { OpF32 o{OB, wo_a, F, D, D, D, D}; hipLaunchKernelGGL(ngemm<OpF32>, dim3(D / 64, M / 64), blk, 0, stream, o); } break;
        case 7: n_np(out, G(0, 3), G(0, 4), XN, 1.0f, 1); break;
        case 8: n_swiglu(0, 1); break;
        case 9: n_out(0, 1); break;
        case 10: n_np(out, G(0, 5), G(1, 0), XN, 0.5f, 1); break;
        case 11: n_swiglu(1, 0); break;
        case 12: n_out(1, 0); break;
        case 13: n_np(out, G(1, 1), G(1, 2), XN2, 0.5f, 2); break;
        case 14: { for (int z = 0; z < 3; ++z) { const int mi = (z == 0) ? 0 : (z == 1 ? 2 : 3);
                       OpRwkvProj o{XN2, mix + mi * D, wrkv + (size_t)z * D * D, RKV + (size_t)z * M * D, D, D, D, D, 0, 0}; hipLaunchKernelGGL(ngemm<OpRwkvProj>, dim3(D / 64, M / 64), blk, 0, stream, o); }
                   OpRwkvProj ow{XN2, mix + 1 * D, w1, LH, D, 64, 64, 512, 1, 0};        hipLaunchKernelGGL(ngemm<OpRwkvProj>, dim3(1, M / 64), blk, 0, stream, ow);
                   OpRwkvProj oa{XN2, mix + 4 * D, a1, LH + 64, D, 64, 64, 512, 0, 0};   hipLaunchKernelGGL(ngemm<OpRwkvProj>, dim3(1, M / 64), blk, 0, stream, oa);
                   OpRwkvProj og{XN2, mix + 5 * D, g1, LH + 128, D, 160, 160, 512, 2, 0}; hipLaunchKernelGGL(ngemm<OpRwkvProj>, dim3(3, M / 64), blk, 0, stream, og); } break;
        case 15: { OpLoraUp ow{LH, w2, w0, DEC, nullptr, 64, D, D, 512, 0, 0};        hipLaunchKernelGGL(ngemm<OpLoraUp>, dim3(D / 64, M / 64), blk, 0, stream, ow);
                   OpLoraUp oa{LH + 64, a2, a0, nullptr, ICL, 64, D, D, 512, 1, 0};   hipLaunchKernelGGL(ngemm<OpLoraUp>, dim3(D / 64, M / 64), blk, 0, stream, oa);
                   OpLoraUp og{LH + 128, g2, nullptr, nullptr, GB, 160, D, D, 512, 2, 0}; hipLaunchKernelGGL(ngemm<OpLoraUp>, dim3(D / 64, M / 64), blk, 0, stream, og); } break;
        case 16: hipLaunchKernelGGL(k_scan, dim3(BATCH * NH), dim3(64), 0, stream, (const bf16*)RKV, (const bf16*)(RKV + (size_t)M * D), (const bf16*)(RKV + (size_t)2 * M * D), (const float*)DEC,
                                    (const bf16*)ICL, (const bf16*)GB, k_k, k_a, r_k, lnx_g, lnx_b, YB); break;
        case 17: case 18: break;
        case 19: { OpF32 o{YB, wo_r, F, D, D, D, D}; hipLaunchKernelGGL(ngemm<OpF32>, dim3(D / 64, M / 64), blk, 0, stream, o); } break;
        case 20: n_np(out, G(1, 3), G(1, 4), XN, 1.0f, 1); break;
        case 21: n_swiglu(1, 1); break;
        case 22: n_out(1, 1); break;
        case 23: n_np(out, G(1, 5), nullptr, XN, 0.5f, 0); break;
        }
    };
    (void)hipMemsetAsync((char*)d_ws + WS_CTL, 0, CTL_ZERO_BYTES, stream);
    Args a{};
    for (int i = 0; i < 24; ++i) a.in[i] = (const float*)d_in[i];
    a.out = out; a.ws = ws;
    const unsigned long long nmask = NAIVE_MASK;
    int li = 0;
    for (int p = 0; p < N_PHASES;) {
        if ((nmask >> p) & 1ull) { naive_phase(p); ++p; continue; }
        int q = p + 1;
        if (ONE_LAUNCH) while (q < N_PHASES && !((nmask >> q) & 1ull)) ++q;
        a.ph_lo = p; a.ph_hi = q; a.li = li++;
        hipLaunchKernelGGL(mega, dim3(grid), dim3(NWAVES * 64), LDS_BYTES, stream, a);
        p = q;
    }
}
```
